# Optimizing an MI355X kernel written in HIP

```python
import math
import jax, jax.numpy as jnp
from jax import lax
import numpy as np

D_MODEL = 1024
BATCH = 8
SEQ = 4096
DEPTH = 1

HEAD_DIM = 64
DSWA_PATTERNS = ((128, 1), (512, 4), (2048, 16))
DSWA_HEADS_PER_GROUP = 4
DSWA_GROUPS = len(DSWA_PATTERNS)
DSWA_HEADS = DSWA_GROUPS * DSWA_HEADS_PER_GROUP
FOX_HEADS = 8
ATTN_BLOCK = 128
NUM_BUCKETS = 32
MAX_DISTANCE = 2048
N_EXPERTS = 32
TOP_K = 4
D_FF_EXPERT = D_MODEL
SWIGLU_LIMIT = 7.0
SWIGLU_ALPHA = 1.702
EXPERT_BLOCK = 256
RMS_EPS = 1e-6
NEG_INF = -1e30

DSWA_WIDTH = DSWA_HEADS * HEAD_DIM
DSWA_OUT_WIDTH = DSWA_HEADS_PER_GROUP * HEAD_DIM
FOX_WIDTH = FOX_HEADS * HEAD_DIM
IN_PROJ_WIDTH = 3 * DSWA_WIDTH + 3 * FOX_WIDTH + FOX_HEADS + 2 * D_MODEL

kernel_name = "hybrid_dilated_fox_moe_layer"


def rmsnorm(x, g):
    xf = x.astype(jnp.float32)
    y = xf * lax.rsqrt(jnp.mean(xf * xf, axis=-1, keepdims=True) + RMS_EPS)
    return (y * g.astype(jnp.float32)).astype(x.dtype)


def t5_bucket(n):
    max_exact = NUM_BUCKETS // 2
    n_safe = np.maximum(n, 1).astype(np.float64)
    large = max_exact + (np.log(n_safe / max_exact) / np.log(MAX_DISTANCE / max_exact)
                         * (NUM_BUCKETS - max_exact)).astype(np.int64)
    large = np.minimum(large, NUM_BUCKETS - 1)
    return np.where(n < max_exact, n, large).astype(np.int32)


def dilated_window_attention(q, k, v, bias_table, window, dilation):
    B, S, H, Dh = q.shape
    steps = window // dilation
    L = S // dilation
    c = math.gcd(L, ATTN_BLOCK)
    nblk = L // c
    span = c + steps

    def by_residue(t):
        return t.reshape(B, L, dilation, H, Dh).transpose(0, 2, 3, 1, 4)

    qs = by_residue(q).reshape(B, dilation, H, nblk, c, Dh)
    pad = ((0, 0), (0, 0), (0, 0), (steps, 0), (0, 0))
    kp = jnp.pad(by_residue(k), pad)
    vp = jnp.pad(by_residue(v), pad)
    key_idx = np.arange(nblk)[:, None] * c + np.arange(span)[None, :]
    kblk = kp[:, :, :, key_idx]
    vblk = vp[:, :, :, key_idx]
    back = np.arange(c)[:, None] + steps - np.arange(span)[None, :]
    valid = ((back >= 0) & (back <= steps))[None] & ((key_idx - steps)[:, None, :] >= 0)
    bucket = t5_bucket(np.clip(back, 0, steps) * dilation)
    bias = jnp.transpose(bias_table[bucket], (2, 0, 1)).astype(jnp.float32)
    s = jnp.einsum('bzhnqd,bzhnkd->bzhnqk', qs, kblk).astype(jnp.float32) * (Dh ** -0.5) + bias[:, None]
    s = jnp.where(valid, s, NEG_INF)
    m = jnp.max(s, axis=-1, keepdims=True)
    p = jnp.exp(s - m)
    den = jnp.sum(p, axis=-1, keepdims=True)
    o = jnp.einsum('bzhnqk,bzhnkd->bzhnqd', p.astype(v.dtype), vblk).astype(jnp.float32) / den
    lse = (m + jnp.log(den))[..., 0]
    o = o.reshape(B, dilation, H, L, Dh).transpose(0, 3, 1, 2, 4).reshape(B, S, H, Dh)
    lse = lse.reshape(B, dilation, H, L).transpose(0, 3, 1, 2).reshape(B, S, H)
    return o, lse


def forgetting_attention(q, k, v, log_f):
    B, S, H, Dh = q.shape
    nq = S // ATTN_BLOCK
    c = jnp.cumsum(log_f, axis=1)
    ck = c.transpose(0, 2, 1)
    qblk = q.reshape(B, nq, ATTN_BLOCK, H, Dh).transpose(1, 0, 2, 3, 4)
    cblk = c.reshape(B, nq, ATTN_BLOCK, H).transpose(1, 0, 3, 2)
    kpos = jnp.arange(S)

    def one_block(args):
        qb, cq, i = args
        s = jnp.einsum('bqhd,bkhd->bhqk', qb, k).astype(jnp.float32) * (Dh ** -0.5)
        s = s + cq[..., None] - ck[:, :, None, :]
        qpos = i * ATTN_BLOCK + jnp.arange(ATTN_BLOCK)
        s = jnp.where(qpos[:, None] >= kpos[None, :], s, NEG_INF)
        p = jax.nn.softmax(s, axis=-1)
        return jnp.einsum('bhqk,bkhd->bqhd', p.astype(v.dtype), v)

    o = lax.map(one_block, (qblk, cblk, jnp.arange(nq)))
    return o.transpose(1, 0, 2, 3, 4).reshape(B, S, H * Dh)


def routed_ffn(h, w_router, b_router, w_gate_up, b_gate_up, w_down, b_down):
    B, S, D = h.shape
    N = B * S
    xt = h.reshape(N, D)
    logits = (xt @ w_router + b_router).astype(jnp.float32)
    top_v, top_i = lax.top_k(logits, TOP_K)
    gate = jax.nn.softmax(top_v, axis=-1)
    A = N * TOP_K
    flat_e = top_i.reshape(-1)
    flat_tok = jnp.arange(A, dtype=jnp.int32) // TOP_K
    order = jnp.argsort(flat_e)
    se = flat_e[order]
    stok = flat_tok[order]
    sgate = gate.reshape(-1)[order]
    counts = jnp.zeros((N_EXPERTS,), jnp.int32).at[flat_e].add(1)
    starts = jnp.cumsum(counts) - counts
    pcounts = ((counts + EXPERT_BLOCK - 1) // EXPERT_BLOCK) * EXPERT_BLOCK
    pends = jnp.cumsum(pcounts)
    pstarts = pends - pcounts
    dest = pstarts[se] + jnp.arange(A, dtype=jnp.int32) - starts[se]
    P = A + N_EXPERTS * EXPERT_BLOCK
    nblk = P // EXPERT_BLOCK
    row_tok = jnp.full((P,), N, jnp.int32).at[dest].set(stok)
    row_gate = jnp.zeros((P,), jnp.float32).at[dest].set(sgate)
    blk_e = jnp.minimum(jnp.searchsorted(pends, jnp.arange(nblk) * EXPERT_BLOCK, side='right'),
                        N_EXPERTS - 1)
    x_pad = jnp.concatenate([xt, jnp.zeros((1, D), xt.dtype)], axis=0)

    def expert_block(args):
        tok, e = args
        xb = x_pad[tok]
        gu = xb @ w_gate_up[e] + b_gate_up[e]
        g, u = gu[:, :D_FF_EXPERT], gu[:, D_FF_EXPERT:]
        g = jnp.minimum(g, SWIGLU_LIMIT)
        u = jnp.clip(u, -SWIGLU_LIMIT, SWIGLU_LIMIT)
        mid = (u + 1) * (g * jax.nn.sigmoid(SWIGLU_ALPHA * g))
        return mid @ w_down[e] + b_down[e]

    yb = lax.map(expert_block, (row_tok.reshape(nblk, EXPERT_BLOCK), blk_e)).reshape(P, D)
    y = jnp.zeros((N + 1, D), h.dtype).at[row_tok].add(yb * row_gate[:, None].astype(yb.dtype))
    return y[:N].reshape(B, S, D)


def hybrid_layer(x, ln1_g, w_in, b_forget, b_gate, q_norm_a, k_norm_a, q_norm_b, k_norm_b, rel_bias,
                 w_branch_a, w_branch_b, w_out, ln2_g, w_router, b_router, w_gate_up, b_gate_up,
                 w_down, b_down):
    B, S, D = x.shape
    h = rmsnorm(x, ln1_g)
    proj = h @ w_in
    o0 = 0
    qa = proj[..., o0:o0 + DSWA_WIDTH]; o0 += DSWA_WIDTH
    ka = proj[..., o0:o0 + DSWA_WIDTH]; o0 += DSWA_WIDTH
    va = proj[..., o0:o0 + DSWA_WIDTH]; o0 += DSWA_WIDTH
    qb = proj[..., o0:o0 + FOX_WIDTH]; o0 += FOX_WIDTH
    kb = proj[..., o0:o0 + FOX_WIDTH]; o0 += FOX_WIDTH
    vb = proj[..., o0:o0 + FOX_WIDTH]; o0 += FOX_WIDTH
    f_logit = proj[..., o0:o0 + FOX_HEADS]; o0 += FOX_HEADS
    g_logit = proj[..., o0:o0 + 2 * D]

    shp_a = (B, S, DSWA_GROUPS, DSWA_HEADS_PER_GROUP, HEAD_DIM)
    qa = rmsnorm(qa.reshape(shp_a), q_norm_a)
    ka = rmsnorm(ka.reshape(shp_a), k_norm_a)
    va = va.reshape(shp_a)
    outs, lses = [], []
    for g, (window, dilation) in enumerate(DSWA_PATTERNS):
        cols = rel_bias[:, g * DSWA_HEADS_PER_GROUP:(g + 1) * DSWA_HEADS_PER_GROUP]
        o, l = dilated_window_attention(qa[:, :, g], ka[:, :, g], va[:, :, g], cols, window, dilation)
        outs.append(o)
        lses.append(l)
    mix = jax.nn.softmax(jnp.stack(lses, axis=0), axis=0)
    o_a = jnp.sum(mix[..., None] * jnp.stack(outs, axis=0), axis=0).astype(x.dtype)
    o_a = o_a.reshape(B, S, DSWA_OUT_WIDTH)

    shp_b = (B, S, FOX_HEADS, HEAD_DIM)
    qb = rmsnorm(qb.reshape(shp_b), q_norm_b)
    kb = rmsnorm(kb.reshape(shp_b), k_norm_b)
    log_f = jax.nn.log_sigmoid((f_logit + b_forget).astype(jnp.float32))
    o_b = forgetting_attention(qb, kb, vb.reshape(shp_b), log_f)

    gate = jax.nn.sigmoid((g_logit + b_gate).astype(jnp.float32)).astype(x.dtype)
    merged = gate[..., :D] * (o_a @ w_branch_a) + gate[..., D:] * (o_b @ w_branch_b)
    x = x + merged @ w_out
    x = x + routed_ffn(rmsnorm(x, ln2_g), w_router, b_router, w_gate_up, b_gate_up, w_down, b_down)
    return x


def setup_inputs(seed: int = 0) -> dict:
    key = jax.random.key(seed)
    ks = jax.random.split(key, 20)
    f32 = jnp.float32
    nrm = lambda k, shape, s: jax.random.normal(k, shape, f32) * s
    return {
        "x": nrm(ks[0], (BATCH, SEQ, D_MODEL), 1.0),
        "ln1_g": 1.0 + nrm(ks[1], (DEPTH, D_MODEL), 0.02),
        "w_in": nrm(ks[2], (DEPTH, D_MODEL, IN_PROJ_WIDTH), D_MODEL ** -0.5),
        "b_forget": jnp.linspace(1.0, 6.0, FOX_HEADS, dtype=f32)[None, :] + nrm(ks[3], (DEPTH, FOX_HEADS), 0.1),
        "b_gate": nrm(ks[4], (DEPTH, 2 * D_MODEL), 0.1),
        "q_norm_a": 1.0 + nrm(ks[5], (DEPTH, HEAD_DIM), 0.02),
        "k_norm_a": 1.0 + nrm(ks[6], (DEPTH, HEAD_DIM), 0.02),
        "q_norm_b": 1.0 + nrm(ks[7], (DEPTH, HEAD_DIM), 0.02),
        "k_norm_b": 1.0 + nrm(ks[8], (DEPTH, HEAD_DIM), 0.02),
        "rel_bias": nrm(ks[9], (NUM_BUCKETS, DSWA_HEADS), 0.5),
        "w_branch_a": nrm(ks[10], (DEPTH, DSWA_OUT_WIDTH, D_MODEL), DSWA_OUT_WIDTH ** -0.5),
        "w_branch_b": nrm(ks[11], (DEPTH, FOX_WIDTH, D_MODEL), FOX_WIDTH ** -0.5),
        "w_out": nrm(ks[12], (DEPTH, D_MODEL, D_MODEL), D_MODEL ** -0.5),
        "ln2_g": 1.0 + nrm(ks[13], (DEPTH, D_MODEL), 0.02),
        "w_router": nrm(ks[14], (DEPTH, D_MODEL, N_EXPERTS), D_MODEL ** -0.5),
        "b_router": nrm(ks[15], (DEPTH, N_EXPERTS), 0.01),
        "w_gate_up": nrm(ks[16], (DEPTH, N_EXPERTS, D_MODEL, 2 * D_FF_EXPERT), D_MODEL ** -0.5),
        "b_gate_up": nrm(ks[17], (DEPTH, N_EXPERTS, 2 * D_FF_EXPERT), 0.01),
        "w_down": nrm(ks[18], (DEPTH, N_EXPERTS, D_FF_EXPERT, D_MODEL), D_FF_EXPERT ** -0.5),
        "b_down": nrm(ks[19], (DEPTH, N_EXPERTS, D_MODEL), 0.01),
    }


def reference(x, ln1_g, w_in, b_forget, b_gate, q_norm_a, k_norm_a, q_norm_b, k_norm_b, rel_bias,
              w_branch_a, w_branch_b, w_out, ln2_g, w_router, b_router, w_gate_up, b_gate_up,
              w_down, b_down):
    for layer in range(DEPTH):
        x = hybrid_layer(x, ln1_g[layer], w_in[layer], b_forget[layer], b_gate[layer],
                         q_norm_a[layer], k_norm_a[layer], q_norm_b[layer], k_norm_b[layer], rel_bias,
                         w_branch_a[layer], w_branch_b[layer], w_out[layer], ln2_g[layer],
                         w_router[layer], b_router[layer], w_gate_up[layer], b_gate_up[layer],
                         w_down[layer], b_down[layer])
    return x
```

```cpp
#include <hip/hip_runtime.h>
#include <hip/hip_bf16.h>
#include <cstdio>
#include <cstdint>
#include <cmath>

#ifndef MK_N_LAUNCHES
#define MK_N_LAUNCHES 1
#endif

#define GAS __attribute__((address_space(1)))
#define LAS __attribute__((address_space(3)))
typedef unsigned short bf16_t;
typedef short bf16x8 __attribute__((ext_vector_type(8)));
typedef short s16x4 __attribute__((ext_vector_type(4)));
typedef float f32x2 __attribute__((ext_vector_type(2)));
typedef float f32x4 __attribute__((ext_vector_type(4)));
typedef float f32x16 __attribute__((ext_vector_type(16)));
typedef unsigned u32x2 __attribute__((ext_vector_type(2)));
typedef unsigned u32x4 __attribute__((ext_vector_type(4)));
typedef GAS unsigned gu32;
#define RLX_AGENT __ATOMIC_RELAXED, __HIP_MEMORY_SCOPE_AGENT
#define LDS_WAIT() asm volatile("s_waitcnt lgkmcnt(0)" ::: "memory")
#define VM_WAIT() asm volatile("s_waitcnt vmcnt(0)" ::: "memory")

constexpr int NB = 8, SEQ = 4096, DM = 1024, NTOK = NB * SEQ;
constexpr int AW = 768, BW = 512, OAW = 256;
constexpr int NPROJ = 5888, WIN_LD = 5896;
constexpr int COL_F = 3840, COL_G = 3848;
constexpr int NEXP = 32, TOPK = 4, ECAP = NTOK;
constexpr float LOG2E = 1.4426950408889634f;
constexpr float QSCALE = 0.125f * LOG2E;
constexpr float RMS_EPS = 1e-6f;

constexpr size_t MiB = 1u << 20;
constexpr size_t WS_CTL = 0, CTL_ZERO_BYTES = 1 * MiB;
constexpr size_t WS_WIN = 2 * MiB;
constexpr size_t WS_WAB = 14 * MiB;
constexpr size_t WS_WO = 16 * MiB;
constexpr size_t WS_WGU = 18 * MiB;
constexpr size_t WS_WD = 146 * MiB;
constexpr size_t WS_LF = 210 * MiB;
constexpr size_t WS_CB = 211 * MiB;
constexpr size_t WS_TOKL = 212 * MiB;
constexpr size_t WS_TINFO = 216 * MiB;
constexpr size_t WS_RGATE = 217 * MiB;
constexpr size_t WS_H = 222 * MiB;
constexpr size_t WS_QA = 286 * MiB, WS_KA = 334 * MiB, WS_VA = 382 * MiB;
constexpr size_t WS_QB = 430 * MiB, WS_KB = 462 * MiB, WS_VB = 494 * MiB;
constexpr size_t WS_GATE = 526 * MiB;
constexpr size_t WS_OG = 654 * MiB;
constexpr size_t WS_LSE = 702 * MiB;
constexpr size_t WS_OAB = 704 * MiB;
constexpr int OABP = 768;
constexpr size_t WS_MRG = 752 * MiB;
constexpr size_t WS_MID = 286 * MiB;
constexpr size_t WS_Y = 558 * MiB;
constexpr size_t WS_H8 = 832 * MiB;
constexpr size_t WS_WIN8 = 864 * MiB;
constexpr size_t WS_RSTD = 868 * MiB;
constexpr size_t WS_ATT = 872 * MiB;
constexpr size_t WS_WIN8ALL = 936 * MiB;
constexpr size_t WS_END = 944 * MiB;
constexpr int PADROWS = NTOK * TOPK + NEXP * 256;
static_assert(WS_MID + (size_t)PADROWS * 1024 * 2 <= WS_Y && WS_Y + (size_t)PADROWS * 1024 * 2 <= WS_END, "ws map");
constexpr int CW_ECNT = 1024;
constexpr int CW_QHEAD = 3072, CW_DSWA_DONE = 3136;
constexpr int CW_BAR = 4096;

constexpr int RING_BYTES = 131072;
constexpr int X_OFF = RING_BYTES;
constexpr int X_MISC = X_OFF;
constexpr int X_TPRE = X_OFF + 512;
constexpr int X_WS = X_OFF + 1024;
constexpr int X_LUT = X_OFF + 3072;
constexpr int X_RCNT = X_OFF + 4096;
constexpr int X_RSEL = X_OFF + 5120;
constexpr int X_Q = X_OFF + 10240;
constexpr int X_RSTD = X_OFF + 10752;
constexpr int X_G2 = X_OFF + 12288;
constexpr int X_NW = X_OFF + 9216;
constexpr int LDS_BYTES = RING_BYTES + 16384;

__device__ __forceinline__ unsigned f2bf(float f) { unsigned u = __builtin_bit_cast(unsigned, f); return (u + 0x7fffu + ((u >> 16) & 1u)) >> 16; }
__device__ __forceinline__ unsigned pk2(float lo, float hi) { return f2bf(lo) | (f2bf(hi) << 16); }
__device__ __forceinline__ float bf2f(unsigned short b) { return __builtin_bit_cast(float, (unsigned)b << 16); }
__device__ __forceinline__ float bflo(unsigned w) { return __builtin_bit_cast(float, w << 16); }
__device__ __forceinline__ float bfhi(unsigned w) { return __builtin_bit_cast(float, w & 0xffff0000u); }
__device__ __forceinline__ float wave_sum(float v) {
#pragma unroll
    for (int o = 1; o < 64; o <<= 1) v += __shfl_xor(v, o);
    return v;
}
__device__ __forceinline__ unsigned pk4_u8(float a, float b, float c, float d) { unsigned w; asm("v_cvt_pk_u8_f32 %0, %1, 0, 0\n\tv_cvt_pk_u8_f32 %0, %2, 1, %0\n\tv_cvt_pk_u8_f32 %0, %3, 2, %0\n\tv_cvt_pk_u8_f32 %0, %4, 3, %0" : "=&v"(w) : "v"(a), "v"(b), "v"(c), "v"(d)); return w; }
__device__ __forceinline__ unsigned pk4_fp8(float a, float b, float c, float d) { int w = 0; w = __builtin_amdgcn_cvt_pk_fp8_f32(a, b, w, false); w = __builtin_amdgcn_cvt_pk_fp8_f32(c, d, w, true); return (unsigned)w; }
__device__ __forceinline__ unsigned pk4_fp8s(float a, float b, float c, float d) { return pk4_fp8(__builtin_amdgcn_fmed3f(a, -448.f, 448.f), __builtin_amdgcn_fmed3f(b, -448.f, 448.f), __builtin_amdgcn_fmed3f(c, -448.f, 448.f), __builtin_amdgcn_fmed3f(d, -448.f, 448.f)); }
constexpr float SC_H2 = 8.0f, SC_MID = 4.0f, SC_W = 256.0f, SC_Y = 16.0f;
constexpr int E8_H2 = 127 - 3, E8_MID = 127 - 2, E8_W = 127 - 8;
__device__ __forceinline__ float sigmoidf_fast(float x) { return __builtin_amdgcn_rcpf(1.0f + __builtin_amdgcn_exp2f(-x * LOG2E)); }

#define XB_TMO      128
#define XB_XCNT(j)  (256  + 64 * (j))
#define XB_XSUB(j)  (1280 + 64 * (j))
#define XB_XGEN(j)  (2304 + 64 * (j))
#define XB_TOP      3328
#define XB_TOPGEN   3392
#define XCD_BAR_WORDS 3456
#define XB_SPIN_CAP (1u << 20)
__device__ __forceinline__ unsigned xb_ld(unsigned* p)              { return __hip_atomic_load(p, __ATOMIC_RELAXED, __HIP_MEMORY_SCOPE_AGENT); }
__device__ __forceinline__ unsigned xb_add(unsigned* p, unsigned v) { return __hip_atomic_fetch_add(p, v, __ATOMIC_RELAXED, __HIP_MEMORY_SCOPE_AGENT); }
__device__ __forceinline__ unsigned xb_xcc_id() { return (unsigned)__builtin_amdgcn_s_getreg((3 << 11) | 20) & 0xFu; }
#define XB_SPIN(cond, bar) do { unsigned _sp = 0; while (cond) { __builtin_amdgcn_s_sleep(1); \
    if ((++_sp & 255u) == 0u) { if (xb_ld(&(bar)[XB_TMO])) break; if (_sp > XB_SPIN_CAP) { atomicAdd(&(bar)[XB_TMO], 1u); break; } } } } while (0)
struct XcdBarrier { unsigned* bar; unsigned x; volatile LAS unsigned* st; };
__device__ __forceinline__ XcdBarrier xcd_barrier_post(unsigned* bar, volatile LAS unsigned* st) {
    XcdBarrier b; b.bar = bar; b.x = xb_xcc_id(); b.st = st;
    if (threadIdx.x == 0) (void)xb_add(&bar[XB_XCNT(b.x)], 1u);
    return b;
}
__device__ __forceinline__ void xcd_barrier_complete(unsigned* bar, unsigned x, unsigned& nloc, unsigned& nx) {
    const unsigned G = gridDim.x * gridDim.y * gridDim.z;
    unsigned sum, cnt, mine, sp = 0u;
    for (;;) {
        sum = 0u; cnt = 0u; mine = 0u;
#pragma unroll
        for (unsigned j = 0; j < 16; ++j) { const unsigned c = xb_ld(&bar[XB_XCNT(j)]); sum += c; cnt += (c > 0u) ? 1u : 0u; mine = (j == x) ? c : mine; }
        if (sum == G) break;
        __builtin_amdgcn_s_sleep(1);
        if ((++sp & 255u) == 0u) { if (xb_ld(&bar[XB_TMO])) break; if (sp > XB_SPIN_CAP) { atomicAdd(&bar[XB_TMO], 1u); break; } }
    }
    nloc = mine > 0u ? mine : 1u; nx = cnt > 0u ? cnt : 1u;
}
__device__ __forceinline__ void xcd_barrier(const XcdBarrier& b) {
    asm volatile("s_waitcnt vmcnt(0)" ::: "memory");
    __syncthreads();
    if (threadIdx.x == 0) {
        unsigned* bar = b.bar;
        __builtin_amdgcn_s_waitcnt(0);
        unsigned nloc = b.st[0], nx = b.st[1];
        if (nloc == 0u) { xcd_barrier_complete(bar, b.x, nloc, nx); b.st[0] = nloc; b.st[1] = nx; }
        const unsigned old = xb_add(&bar[XB_XSUB(b.x)], 1u);
        const unsigned gen = old / nloc;
        if (old + 1u == (gen + 1u) * nloc) {
            __builtin_amdgcn_fence(__ATOMIC_RELEASE, "agent");
            asm volatile("s_waitcnt vmcnt(0)" ::: "memory");
            const unsigned og = xb_add(&bar[XB_TOP], 1u);
            const unsigned tg = og / nx;
            if (og + 1u == (tg + 1u) * nx) xb_add(&bar[XB_TOPGEN], 1u);
            else XB_SPIN(xb_ld(&bar[XB_TOPGEN]) == tg, bar);
            __builtin_amdgcn_fence(__ATOMIC_ACQUIRE, "agent");
            xb_add(&bar[XB_XGEN(b.x)], 1u);
            asm volatile("s_waitcnt vmcnt(0)" ::: "memory");
        } else {
            XB_SPIN(xb_ld(&bar[XB_XGEN(b.x)]) == gen, bar);
            __builtin_amdgcn_fence(__ATOMIC_ACQUIRE, "agent");
            asm volatile("s_waitcnt vmcnt(0)" ::: "memory");
        }
    }
    __syncthreads();
}

namespace pg8 {
constexpr int BM = 256, BK = 64, HALF = 128, HTB = HALF * BK * 2, STAGE_BYTES = 8 * HTB, NXCD = 8, WGM = 8;
__host__ __device__ __forceinline__ int lds_byte(int r, int c) { const int st = (r >> 4) * 2 + (c >> 5), rr = r & 15, cc = c & 31, ob = rr * 64 + cc * 2; return st * 1024 + (ob ^ (((ob >> 9) & 1) << 5)); }
__host__ __device__ __forceinline__ void stage_rc(int b, int& R, int& C) { const int st = b / 1024, sb = b % 1024, swz = sb ^ (((sb >> 9) & 1) << 5); R = (st >> 1) * 16 + swz / 64; C = (st & 1) * 32 + (swz % 64) / 2; }
__host__ __device__ __forceinline__ void stage_rc_u(unsigned b, unsigned& R, unsigned& C) { const unsigned st = b >> 10, sb = b & 1023u, swz = sb ^ (((sb >> 9) & 1u) << 5); R = (st >> 1) * 16u + (swz >> 6); C = (st & 1u) * 32u + ((swz & 63u) >> 1); }
__host__ __device__ __forceinline__ int perm32b(int rho) { const int n = rho >> 4, i = rho & 15, fq = i >> 2; return 16 * (fq & 1) + 8 * (fq >> 1) + 4 * n + (i & 3); }
__host__ __device__ __forceinline__ int perm32(int rho) { const int n = rho >> 4, i = rho & 15; return 8 * (i >> 2) + 4 * n + (i & 3); }

struct Unit { int pm, pn, e, mt; };

struct StaticOrder {
    static constexpr bool GATHER = false;
    const bf16_t* A; const bf16_t* Bt; int K;
    int nM, nN, nwg, G, c;
    __device__ void init(const bf16_t* A_, const bf16_t* Bt_, int M, int N, int K_, int G_, int c_) { A = A_; Bt = Bt_; K = K_; nM = M / BM; nN = N / BM; nwg = nM * nN; G = G_; c = c_; }
    __device__ bool next(int i, Unit& u) const {
        const long L = (long)i * G + c; if (L >= nwg) return false;
        int wgid = (int)L; { const int q = nwg / NXCD, r = nwg % NXCD, xcd = wgid % NXCD, off = wgid / NXCD; wgid = (xcd < r ? xcd * (q + 1) : r * (q + 1) + (xcd - r) * q) + off; }
        const int nig = WGM * nN, gid = wgid / nig, fm = gid * WGM, gsz = (nM - fm) < WGM ? (nM - fm) : WGM;
        u.pm = fm + ((wgid % nig) % gsz); u.pn = (wgid % nig) / gsz; u.e = 0; u.mt = u.pm; return true;
    }
    __device__ __forceinline__ const char* a_base(const Unit& u) const { return (const char*)A + (size_t)u.pm * BM * K * 2; }
    __device__ __forceinline__ const char* b_base(const Unit& u) const { return (const char*)Bt + (size_t)u.pn * BM * K * 2; }
    __device__ __forceinline__ void a_voff(const Unit&, const int (&R)[2], const int (&C)[2], unsigned (&v)[2][2]) const {
#pragma unroll
        for (int h = 0; h < 2; ++h)
#pragma unroll
            for (int i = 0; i < 2; ++i) v[h][i] = (unsigned)((R[i] + HALF * h) * K + C[i]) * 2u;
    }
};
template <bool GATHER_, int XM> struct ExpertOrder {
    static constexpr bool GATHER = GATHER_;
    const bf16_t* A; const bf16_t* Bt; int K, N; const int* tokl;
    const LAS int* tpre; const LAS int* ecnt; int nN, G, c;
    __device__ bool next(int i, Unit& u) const {
        const int total = tpre[NEXP];
        int mt_all, pn;
        if ((G & 7) == 0) { const long Lq = (long)i * G + c; const int x = (int)(Lq & 7); const long r = Lq >> 3; const int q = (nN * XM) >> 3;
            mt_all = XM * (int)(r / q) + (x % XM); pn = q * (x / XM) + (int)(r % q); }
        else { const long Lq = (long)i * G + c; mt_all = (int)(Lq / nN); pn = (int)(Lq % nN); }
        if (mt_all >= total) return false;
        u.pn = pn; u.pm = mt_all;
        int e = 0;
#pragma unroll
        for (int s = 16; s >= 1; s >>= 1) { if (tpre[e + s] <= mt_all) e += s; }
        u.e = e; u.mt = mt_all - tpre[e]; return true;
    }
    __device__ __forceinline__ const char* a_base(const Unit& u) const { return GATHER ? (const char*)A : (const char*)A + (size_t)u.pm * BM * K * 2; }
    __device__ __forceinline__ const char* b_base(const Unit& u) const { return (const char*)Bt + ((size_t)u.e * N + (size_t)u.pn * BM) * K * 2; }
    __device__ __forceinline__ void a_voff(const Unit& u, const int (&R)[2], const int (&C)[2], unsigned (&v)[2][2]) const {
        if constexpr (GATHER) {
            const int cnt = ecnt[u.e];
#pragma unroll
            for (int h = 0; h < 2; ++h)
#pragma unroll
                for (int i = 0; i < 2; ++i) { const int pos = u.mt * BM + R[i] + HALF * h; const int tk = tokl[(size_t)u.e * ECAP + (pos < cnt ? pos : 0)]; const int tok = (pos < cnt) ? tk : 0;
                    v[h][i] = (unsigned)(tok * K + C[i]) * 2u; }
        } else {
#pragma unroll
            for (int h = 0; h < 2; ++h)
#pragma unroll
                for (int i = 0; i < 2; ++i) v[h][i] = (unsigned)((R[i] + HALF * h) * K + C[i]) * 2u;
        }
    }
};

typedef __bf16 bf16x2v __attribute__((ext_vector_type(2)));
__device__ __forceinline__ unsigned cvt_pk_bf16(float lo, float hi) { f32x2 v = {lo, hi}; bf16x2v b = __builtin_convertvector(v, bf16x2v); return __builtin_bit_cast(unsigned, b); }

typedef int i32x4 __attribute__((ext_vector_type(4)));
typedef int i32x8 __attribute__((ext_vector_type(8)));
__host__ __device__ __forceinline__ i32x8 cat8(bf16x8 a, bf16x8 b) { const i32x4 x = __builtin_bit_cast(i32x4, a), y = __builtin_bit_cast(i32x4, b); return __builtin_shufflevector(x, y, 0, 1, 2, 3, 4, 5, 6, 7); }
template <class Epi, class Sched, int FP8SC = 0>
__device__ __forceinline__ void gemm_phase(LAS unsigned char* lds, const Sched& S, const Epi& E) {
    const int tid = threadIdx.x, wid = __builtin_amdgcn_readfirstlane(tid >> 6), lane = tid & 63, wr = wid >> 2, wc = wid & 3, fr = lane & 15, fq = lane >> 4;
    const int K = S.K, nt = K / BK;
    int Rp[2], Cp[2]; unsigned voffB[2];
#pragma unroll
    for (int i = 0; i < 2; ++i) { stage_rc(tid * 16 + i * 8192, Rp[i], Cp[i]); const int Rb = Epi::PERM == 2 ? ((Rp[i] & ~31) + perm32b(Rp[i] & 31)) : Epi::PERM ? ((Rp[i] & ~31) + perm32(Rp[i] & 31)) : Rp[i]; voffB[i] = (unsigned)(Rb * K + Cp[i]) * 2u; }
    const size_t kstep = (size_t)(BK * 2);
    const size_t hstep = (size_t)HALF * K * 2;
    const unsigned ldsw = (unsigned)wid * 1024u;
    int aoff = lds_byte(wr * 64 + fr, fq * 8), boff = lds_byte(wc * 32 + fr, fq * 8);
#define PG8_SA(b, h) (((b) * 2 + (h)) * HTB)
#define PG8_SB(b, h) ((4 + (b) * 2 + (h)) * HTB)
#define PG8_STAGE(bufoff, gbase, voff) do { _Pragma("unroll") for (int _i = 0; _i < 2; ++_i) \
        __builtin_amdgcn_global_load_lds((const unsigned*)((const char*)(gbase) + (voff)[_i]), (LAS unsigned*)(lds + (bufoff) + ldsw + _i * 8192), 16, 0, 0); } while (0)
#define PG8_LD8(p) cat8(*(const LAS bf16x8*)(p), *(const LAS bf16x8*)((p) + 1024))
#define PG8_LDA(dst, b, h) do { if constexpr (FP8SC != 0) { _Pragma("unroll") for (int m = 0; m < 4; ++m) dst##8[m] = PG8_LD8(lds + PG8_SA(b, h) + aoff + m * 2048); } \
        else { _Pragma("unroll") for (int m = 0; m < 4; ++m) _Pragma("unroll") for (int k = 0; k < 2; ++k) dst[m][k] = *(const LAS bf16x8*)(lds + PG8_SA(b, h) + aoff + m * 2048 + k * 1024); } } while (0)
#define PG8_LDB(dst, b, h) do { if constexpr (FP8SC != 0) { _Pragma("unroll") for (int n = 0; n < 2; ++n) dst##8[n] = PG8_LD8(lds + PG8_SB(b, h) + boff + n * 2048); } \
        else { _Pragma("unroll") for (int n = 0; n < 2; ++n) _Pragma("unroll") for (int k = 0; k < 2; ++k) dst[n][k] = *(const LAS bf16x8*)(lds + PG8_SB(b, h) + boff + n * 2048 + k * 1024); } } while (0)
#define PG8_MMA(ai, bj, At, Bt) do { __builtin_amdgcn_s_setprio(1); \
        if constexpr (FP8SC != 0) { _Pragma("unroll") for (int m = 0; m < 4; ++m) _Pragma("unroll") for (int n = 0; n < 2; ++n) \
            asm volatile("v_mfma_scale_f32_16x16x128_f8f6f4 %0, %1, %2, %0, %3, %4 op_sel_hi:[0,0,0]" : "+v"(acc[ai][bj][m][n]) : "v"(Bt##8[n]), "v"(At##8[m]), "v"(scw), "v"(sca)); } \
        else { _Pragma("unroll") for (int m = 0; m < 4; ++m) _Pragma("unroll") for (int n = 0; n < 2; ++n) _Pragma("unroll") for (int k = 0; k < 2; ++k) \
            acc[ai][bj][m][n] = __builtin_amdgcn_mfma_f32_16x16x32_bf16(Bt[n][k], At[m][k], acc[ai][bj][m][n], 0, 0, 0); } \
        __builtin_amdgcn_s_setprio(0); } while (0)
#define PG8_WAIT_V(n) asm volatile("s_waitcnt vmcnt(" #n ")" ::: "memory")
#define PG8_WAIT_VR(c) asm volatile("v_cmp_eq_u32_e32 vcc, 0, %0\n\ts_cbranch_vccnz 1f\n\ts_waitcnt vmcnt(%1)\n\ts_branch 2f\n1:\n\ts_waitcnt vmcnt(8)\n2:" :: "v"(c), "n"(8 + Epi::NST) : "memory", "vcc")
#define PG8_WAIT_L(n) asm volatile("s_waitcnt lgkmcnt(" #n ")" ::: "memory")
#define PG8_BAR __builtin_amdgcn_s_barrier()
#define PG8_SCHED __builtin_amdgcn_sched_barrier(0)
    Unit cur, nxt; int ui = 0;
    if (!S.next(0, cur)) return;
    unsigned voffA[2][2], voffN[2][2];
    S.a_voff(cur, Rp, Cp, voffA);
#pragma unroll
    for (int h = 0; h < 2; ++h)
#pragma unroll
        for (int i = 0; i < 2; ++i) voffN[h][i] = voffA[h][i];
    f32x4 acc[2][2][4][2];
#pragma unroll
    for (int a = 0; a < 2; ++a)
#pragma unroll
        for (int b = 0; b < 2; ++b)
#pragma unroll
            for (int m = 0; m < 4; ++m)
#pragma unroll
                for (int n = 0; n < 2; ++n) acc[a][b][m][n] = (f32x4){0.f, 0.f, 0.f, 0.f};
    bf16x8 At[4][2], B0[2][2], B1[2][2]; i32x8 At8[4], B08[2], B18[2];
    int scw = E8_W * 0x01010101, sca = FP8SC * 0x01010101; asm volatile("" : "+v"(scw), "+v"(sca));
    const char* cA = S.a_base(cur); const char* cB = S.b_base(cur);
    PG8_STAGE(PG8_SB(0, 0), cB, voffB); PG8_STAGE(PG8_SB(0, 1), cB + hstep, voffB); PG8_STAGE(PG8_SA(0, 0), cA, voffA[0]); PG8_STAGE(PG8_SA(0, 1), cA, voffA[1]);
    if (wr == 1) PG8_BAR;
    PG8_WAIT_V(2); PG8_BAR;
    PG8_STAGE(PG8_SB(1, 0), cB + kstep, voffB); PG8_STAGE(PG8_SA(1, 0), cA + kstep, voffA[0]); PG8_STAGE(PG8_SB(1, 1), cB + hstep + kstep, voffB);
    PG8_WAIT_V(6); PG8_BAR;
    for (;;) {
        const bool has_next = S.next(ui + 1, nxt);
        const char* nA = has_next ? S.a_base(nxt) : cA; const char* nB = has_next ? S.b_base(nxt) : cB;
        if constexpr (Sched::GATHER) { if (has_next) S.a_voff(nxt, Rp, Cp, voffN); }
#ifndef KREP
#define KREP 1
#endif
        for (int rep = 0; rep < KREP; ++rep) { const bool fin = (rep == KREP - 1);
        for (int t = 0; t < nt; t += 2) {
            const bool last = (t == nt - 2);
            if constexpr (Epi::MIDT > 0) { if (fin && t == Epi::MIDT) { int et_ = threadIdx.x; asm volatile("" : "+v"(et_)); E.mid(acc, cur, wr, wc, et_ & 15, (et_ >> 4) & 3); } }
            const char* a1 = cA + (size_t)(t + 1) * kstep;
            const char* a2 = last ? (fin ? nA : cA) : cA + (size_t)(t + 2) * kstep; const char* b2 = last ? (fin ? nB : cB) : cB + (size_t)(t + 2) * kstep;
            const char* a3 = a2 + kstep; const char* b3 = b2 + kstep;
            unsigned v2[2][2];
#pragma unroll
            for (int h = 0; h < 2; ++h)
#pragma unroll
                for (int i = 0; i < 2; ++i) v2[h][i] = (Sched::GATHER && last && fin) ? voffN[h][i] : voffA[h][i];
            const int rlx = ((t == 0) && (ui > 0) && (rep == 0)) ? 1 : 0;
            PG8_LDB(B0, 0, 0); PG8_LDB(B1, 0, 1); PG8_SCHED; PG8_LDA(At, 0, 0); PG8_STAGE(PG8_SA(1, 1), a1, voffA[1]);
            PG8_WAIT_VR(rlx);
            PG8_WAIT_L(0); PG8_BAR; PG8_MMA(0, 0, At, B0); PG8_MMA(0, 1, At, B1); PG8_BAR; PG8_SCHED;
            PG8_LDA(At, 0, 1); PG8_STAGE(PG8_SB(0, 0), b2, voffB); PG8_STAGE(PG8_SB(0, 1), b2 + hstep, voffB); PG8_STAGE(PG8_SA(0, 0), a2, v2[0]);
            PG8_WAIT_VR(rlx);
            PG8_WAIT_L(0); PG8_BAR; PG8_MMA(1, 0, At, B0); PG8_MMA(1, 1, At, B1); PG8_BAR; PG8_SCHED;
            PG8_LDB(B0, 1, 0); PG8_LDB(B1, 1, 1); PG8_SCHED; PG8_LDA(At, 1, 0); PG8_STAGE(PG8_SA(0, 1), a2, v2[1]);
            PG8_WAIT_V(8); PG8_WAIT_L(0); PG8_BAR; PG8_MMA(0, 0, At, B0); PG8_MMA(0, 1, At, B1); PG8_BAR; PG8_SCHED;
            PG8_LDA(At, 1, 1); PG8_STAGE(PG8_SB(1, 0), b3, voffB); PG8_STAGE(PG8_SB(1, 1), b3 + hstep, voffB); PG8_STAGE(PG8_SA(1, 0), a3, v2[0]);
            PG8_WAIT_V(8); PG8_WAIT_L(0); PG8_BAR; PG8_MMA(1, 0, At, B0); PG8_MMA(1, 1, At, B1); PG8_BAR; PG8_SCHED;
        }
        if (!fin) {
#pragma unroll
        for (int a = 0; a < 2; ++a)
#pragma unroll
            for (int b = 0; b < 2; ++b)
#pragma unroll
                for (int m = 0; m < 4; ++m)
#pragma unroll
                    for (int n = 0; n < 2; ++n) acc[a][b][m][n] = (f32x4){0.f, 0.f, 0.f, 0.f};
        } }
        if (wr == 0) PG8_BAR;
        if constexpr (FP8SC != 0) asm volatile("s_nop 15\n\ts_nop 15" ::: "memory");
        { int et_ = threadIdx.x; asm volatile("" : "+v"(et_)); const int efr = et_ & 15, efq = (et_ >> 4) & 3;
          E(acc, cur, wr, wc, efr, efq); }
        if (!has_next) break;
#pragma unroll
        for (int a = 0; a < 2; ++a)
#pragma unroll
            for (int b = 0; b < 2; ++b)
#pragma unroll
                for (int m = 0; m < 4; ++m)
#pragma unroll
                    for (int n = 0; n < 2; ++n) acc[a][b][m][n] = (f32x4){0.f, 0.f, 0.f, 0.f};
        cur = nxt; cA = nA; cB = nB; ++ui;
#pragma unroll
        for (int h = 0; h < 2; ++h)
#pragma unroll
            for (int i = 0; i < 2; ++i) voffA[h][i] = voffN[h][i];
        if (wr == 1) PG8_BAR;
    }
    PG8_WAIT_V(0);
    PG8_BAR;
#undef PG8_SA
#undef PG8_SB
#undef PG8_STAGE
#undef PG8_LDA
#undef PG8_LD8
#undef PG8_LDB
#undef PG8_MMA
#undef PG8_WAIT_V
#undef PG8_WAIT_VR
#undef PG8_WAIT_L
#undef PG8_BAR
#undef PG8_SCHED
}

typedef const f32x4 (&AccRef)[2][2][4][2];
#ifndef EPDUP_MODE
#define EPDUP_MODE 0
#endif
#if EPDUP_MODE == 2
__device__ unsigned char* epdup_base;
#endif
template <class P> __device__ __forceinline__ void epst(P* p, u32x4 v) {
    *(u32x4*)p = v;
#if EPDUP_MODE == 1
    *(volatile u32x4*)p = v;
#elif EPDUP_MODE == 2
    *(volatile u32x4*)(epdup_base + (size_t)blockIdx.x * 16384 + (threadIdx.x >> 6) * 2048 + (threadIdx.x & 63) * 16) = v;
#endif
}
#define EPST(p, v) epst((p), (v))
__device__ __forceinline__ u32x4 pair_rows(u32x2 X, u32x2 Y) { const auto a = __builtin_amdgcn_permlane32_swap(X.x, Y.x, false, false), b = __builtin_amdgcn_permlane32_swap(X.y, Y.y, false, false);
    u32x4 o; o.x = a[0]; o.y = b[0]; o.z = a[1]; o.w = b[1]; return o; }
#define DEAL_SRC(ln) ((((ln) & 3) << 6) | (((ln) >> 2) << 2))
__device__ __forceinline__ u32x4 deal4(u32x4 v, int bpa) { u32x4 t; t.x = (unsigned)__builtin_amdgcn_ds_bpermute(bpa, (int)v.x); t.y = (unsigned)__builtin_amdgcn_ds_bpermute(bpa, (int)v.y);
    t.z = (unsigned)__builtin_amdgcn_ds_bpermute(bpa, (int)v.z); t.w = (unsigned)__builtin_amdgcn_ds_bpermute(bpa, (int)v.w); return t; }
__device__ __forceinline__ u32x2 deal2(u32x2 v, int bpa) { u32x2 t; t.x = (unsigned)__builtin_amdgcn_ds_bpermute(bpa, (int)v.x); t.y = (unsigned)__builtin_amdgcn_ds_bpermute(bpa, (int)v.y); return t; }
__device__ __forceinline__ u32x4 pack8(const f32x4& a, const f32x4& b) { u32x4 w; w.x = cvt_pk_bf16(a[0], a[1]); w.y = cvt_pk_bf16(a[2], a[3]); w.z = cvt_pk_bf16(b[0], b[1]); w.w = cvt_pk_bf16(b[2], b[3]); return w; }

template <int MODE> struct EpiInProj {
    static constexpr bool PERM = true; static constexpr int MIDT = 0, NST = 16;
    unsigned char* ws; const LAS float* nwl; const float* bgate;
    __device__ __forceinline__ void operator()(AccRef acc, const Unit& u, int wr, int wc, int fr, int fq) const {
        const int row0 = u.pm * BM + wr * 64 + fr;
        const int ln = fr + 16 * fq, bpa = DEAL_SRC(ln), rowd = u.pm * BM + wr * 64 + (ln >> 2), c4 = ln & 3;
        const int pn = u.pn;
        if (pn < 15) {
            int s, hb, pitch, nwi; size_t boff;
            if (pn < 9) { s = pn / 3; hb = 4 * (pn - 3 * s); pitch = AW; boff = WS_QA + (size_t)s * (WS_KA - WS_QA); nwi = s; }
            else { const int p2 = pn - 9; s = p2 >> 1; hb = 4 * (p2 & 1); pitch = BW; boff = WS_QB + (size_t)s * (WS_KB - WS_QB); nwi = 2 + s; }
            bf16_t* base = (bf16_t*)(ws + boff);
            const bool nrm = s < 2;
            const int colb = (hb + wc) * 64 + 8 * fq;
            f32x4 w[2][2];
#pragma unroll
            for (int bj = 0; bj < 2; ++bj)
#pragma unroll
                for (int n = 0; n < 2; ++n) { const f32x4 t = *(const LAS f32x4*)(nwl + (nrm ? nwi : 0) * 64 + 32 * bj + 8 * fq + 4 * n); w[bj][n] = nrm ? t : (f32x4){1.f, 1.f, 1.f, 1.f}; }
#pragma unroll
            for (int ai = 0; ai < 2; ++ai)
#pragma unroll
                for (int m = 0; m < 4; ++m) {
                    float ss = 0.f;
#pragma unroll
                    for (int bj = 0; bj < 2; ++bj)
#pragma unroll
                        for (int n = 0; n < 2; ++n) { const f32x4 x = acc[ai][bj][m][n]; ss += (x[0] * x[0] + x[1] * x[1]) + (x[2] * x[2] + x[3] * x[3]); }
                    ss += __shfl_xor(ss, 16); ss += __shfl_xor(ss, 32);
                    const float r = nrm ? __builtin_amdgcn_rsqf(ss * (1.0f / 64.0f) + RMS_EPS) : 1.0f;
                    bf16_t* rowp = base + (size_t)(rowd + ai * HALF + m * 16) * pitch + (hb + wc) * 64 + 8 * c4;
#pragma unroll
                    for (int bj = 0; bj < 2; ++bj) { const f32x4 v0 = acc[ai][bj][m][0] * (w[bj][0] * r), v1 = acc[ai][bj][m][1] * (w[bj][1] * r); EPST(rowp + 32 * bj, deal4(pack8(v0, v1), bpa)); }
                }
        } else {
            unsigned char* gate = ws + WS_GATE;
            const int colb = 256 * (pn - 15) + 64 * wc + 8 * fq;
            f32x4 bb[2][2];
#pragma unroll
            for (int bj = 0; bj < 2; ++bj)
#pragma unroll
                for (int n = 0; n < 2; ++n) bb[bj][n] = *(const f32x4*)(bgate + colb + 32 * bj + 4 * n);
#pragma unroll
            for (int ai = 0; ai < 2; ++ai)
#pragma unroll
                for (int m = 0; m < 4; ++m) { unsigned char* rowp = gate + (size_t)(rowd + ai * HALF + m * 16) * 2048 + 256 * (pn - 15) + 64 * wc + 8 * c4;
#pragma unroll
                    for (int bj = 0; bj < 2; ++bj) { f32x4 v0 = (acc[ai][bj][m][0] + bb[bj][0]) * (-LOG2E), v1 = (acc[ai][bj][m][1] + bb[bj][1]) * (-LOG2E);
#pragma unroll
                        for (int e = 0; e < 4; ++e) { v0[e] = __builtin_amdgcn_exp2f(v0[e]); v1[e] = __builtin_amdgcn_exp2f(v1[e]); }
                        v0 = v0 + 1.0f; v1 = v1 + 1.0f;
#pragma unroll
                        for (int e = 0; e < 4; ++e) { v0[e] = __builtin_amdgcn_rcpf(v0[e]); v1[e] = __builtin_amdgcn_rcpf(v1[e]); }
                        v0 = v0 * 255.0f; v1 = v1 * 255.0f;
#pragma unroll
                        for (int e = 0; e < 4; ++e) { v0[e] = __builtin_rintf(v0[e]); v1[e] = __builtin_rintf(v1[e]); }
                        u32x2 o; o.x = pk4_u8(v0[0], v0[1], v0[2], v0[3]); o.y = pk4_u8(v1[0], v1[1], v1[2], v1[3]);
                        *(u32x2*)(rowp + 32 * bj) = deal2(o, bpa); } }
        }
    }
};
template <bool SECOND> struct EpiBranch {
    static constexpr bool PERM = true; static constexpr int MIDT = 0, NST = 16;
    const bf16_t* gate; bf16_t* mrg;
    __device__ __forceinline__ void operator()(AccRef acc, const Unit& u, int wr, int wc, int fr, int fq) const {
        const int row0 = u.pm * BM + wr * 64 + fr, col0 = u.pn * BM + wc * 32 + 8 * fq;
#pragma unroll
        for (int ai = 0; ai < 2; ++ai) {
            u32x4 gv[4][2], tv[4][2];
#pragma unroll
            for (int m = 0; m < 4; ++m) { const size_t row = (size_t)(row0 + ai * HALF + m * 16);
#pragma unroll
                for (int bj = 0; bj < 2; ++bj) { const int col = col0 + bj * HALF; gv[m][bj] = *(const u32x4*)(gate + row * 2048 + (SECOND ? 1024 : 0) + col);
                    if (SECOND) tv[m][bj] = *(const u32x4*)(mrg + row * 1024 + col); } }
            asm volatile("" ::: "memory");
#pragma unroll
            for (int m = 0; m < 4; ++m) { const size_t row = (size_t)(row0 + ai * HALF + m * 16);
#pragma unroll
                for (int bj = 0; bj < 2; ++bj) { const int col = col0 + bj * HALF; const u32x4 g = gv[m][bj];
                    const f32x4 g0 = {bflo(g.x), bfhi(g.x), bflo(g.y), bfhi(g.y)}, g1 = {bflo(g.z), bfhi(g.z), bflo(g.w), bfhi(g.w)};
                    f32x4 v0 = acc[ai][bj][m][0] * g0, v1 = acc[ai][bj][m][1] * g1;
                    if (SECOND) { const u32x4 t = tv[m][bj]; const f32x4 t0 = {bflo(t.x), bfhi(t.x), bflo(t.y), bfhi(t.y)}, t1 = {bflo(t.z), bfhi(t.z), bflo(t.w), bfhi(t.w)}; v0 = v0 + t0; v1 = v1 + t1; }
                    *(u32x4*)(mrg + row * 1024 + col) = pack8(v0, v1); } }
            asm volatile("" ::: "memory");
        }
    }
};
struct EpiMerge {
    static constexpr bool PERM = true; static constexpr int MIDT = 4, NST = 16;
    const unsigned char* gate; bf16_t* mrg;
    static __device__ __forceinline__ f32x4 ub4(unsigned w) { return (f32x4){(float)(w & 255u), (float)((w >> 8) & 255u), (float)((w >> 16) & 255u), (float)(w >> 24)}; }
    __device__ __forceinline__ void mid(f32x4 (&acc)[2][2][4][2], const Unit& u, int wr, int wc, int fr, int fq) const {
        const int row0 = u.pm * BM + wr * 64 + fr, col0 = u.pn * BM + wc * 32 + 8 * fq;
        u32x2 ga[2][4][2], gb[2][4][2];
#pragma unroll
        for (int ai = 0; ai < 2; ++ai)
#pragma unroll
            for (int m = 0; m < 4; ++m) { const size_t row = (size_t)(row0 + ai * HALF + m * 16);
#pragma unroll
                for (int bj = 0; bj < 2; ++bj) { const int col = col0 + bj * HALF; ga[ai][m][bj] = *(const u32x2*)(gate + row * 2048 + col); gb[ai][m][bj] = *(const u32x2*)(gate + row * 2048 + 1024 + col); } }
#pragma unroll
        for (int ai = 0; ai < 2; ++ai)
#pragma unroll
            for (int m = 0; m < 4; ++m)
#pragma unroll
                for (int bj = 0; bj < 2; ++bj) { const u32x2 a = ga[ai][m][bj], b = gb[ai][m][bj];
                    const f32x4 a0 = ub4(a.x), a1 = ub4(a.y); f32x4 b0 = ub4(b.x), b1 = ub4(b.y);
#pragma unroll
                    for (int e = 0; e < 4; ++e) { b0[e] = __builtin_amdgcn_rcpf(fmaxf(b0[e], 2.0116e-28f)); b1[e] = __builtin_amdgcn_rcpf(fmaxf(b1[e], 2.0116e-28f)); }
                    acc[ai][bj][m][0] = acc[ai][bj][m][0] * (a0 * b0); acc[ai][bj][m][1] = acc[ai][bj][m][1] * (a1 * b1); }
    }
    __device__ __forceinline__ void operator()(AccRef acc, const Unit& u, int wr, int wc, int fr, int fq) const {
        const int row0 = u.pm * BM + wr * 64 + fr, col0 = u.pn * BM + wc * 32 + 8 * fq;
        const int ln = fr + 16 * fq, bpa = DEAL_SRC(ln), rowd = u.pm * BM + wr * 64 + (ln >> 2), cold = u.pn * BM + wc * 32 + 8 * (ln & 3);
        u32x2 gb[2][4][2];
#pragma unroll
        for (int ai = 0; ai < 2; ++ai)
#pragma unroll
            for (int m = 0; m < 4; ++m) { const size_t row = (size_t)(row0 + ai * HALF + m * 16);
#pragma unroll
                for (int bj = 0; bj < 2; ++bj) gb[ai][m][bj] = *(const u32x2*)(gate + row * 2048 + 1024 + col0 + bj * HALF); }
#pragma unroll
        for (int ai = 0; ai < 2; ++ai)
#pragma unroll
            for (int m = 0; m < 4; ++m)
#pragma unroll
                for (int bj = 0; bj < 2; ++bj) { const u32x2 b = gb[ai][m][bj];
                    f32x4 b0 = ub4(b.x), b1 = ub4(b.y);
#pragma unroll
                    for (int e = 0; e < 4; ++e) { b0[e] = fmaxf(b0[e], 2.0116e-28f) * (1.0f / 255.0f); b1[e] = fmaxf(b1[e], 2.0116e-28f) * (1.0f / 255.0f); }
                    EPST(mrg + (size_t)(rowd + ai * HALF + m * 16) * 1024 + cold + bj * HALF, deal4(pack8(acc[ai][bj][m][0] * b0, acc[ai][bj][m][1] * b1), bpa)); }
    }
};
struct EpiAtt {
    static constexpr bool PERM = true; static constexpr int MIDT = 0, NST = 16;
    const float* x; bf16_t* x1;
    __device__ __forceinline__ void operator()(AccRef acc, const Unit& u, int wr, int wc, int fr, int fq) const {
        const int row0 = u.pm * BM + wr * 64 + fr, col0 = u.pn * BM + wc * 32 + 8 * fq;
        const int ln = fr + 16 * fq, bpa = DEAL_SRC(ln), rowd = u.pm * BM + wr * 64 + (ln >> 2), cold = u.pn * BM + wc * 32 + 8 * (ln & 3);
#pragma unroll
        for (int ai = 0; ai < 2; ++ai) {
            f32x4 xv[4][2][2];
#pragma unroll
            for (int m = 0; m < 4; ++m) { const float* xp = x + (size_t)(row0 + ai * HALF + m * 16) * DM + col0;
#pragma unroll
                for (int bj = 0; bj < 2; ++bj) { xv[m][bj][0] = __builtin_nontemporal_load((const f32x4*)(xp + bj * HALF)); xv[m][bj][1] = __builtin_nontemporal_load((const f32x4*)(xp + bj * HALF + 4)); } }
            asm volatile("" ::: "memory");
#pragma unroll
            for (int m = 0; m < 4; ++m) { bf16_t* rowp = x1 + (size_t)(rowd + ai * HALF + m * 16) * DM + cold;
#pragma unroll
                for (int bj = 0; bj < 2; ++bj) EPST(rowp + bj * HALF, deal4(pack8(acc[ai][bj][m][0] + xv[m][bj][0], acc[ai][bj][m][1] + xv[m][bj][1]), bpa)); }
            asm volatile("" ::: "memory");
        }
    }
};
struct EpiSwiglu {
    static constexpr int PERM = 2; static constexpr int MIDT = 0, NST = 4;
    const float* bgu; unsigned char* mid; const float* rstds; const LAS int* ecnt;
    __device__ __forceinline__ void operator()(AccRef acc, const Unit& u, int wr, int wc, int fr, int fq) const {
        const int col0 = u.pn * HALF + wc * 32 + 16 * (fq & 1) + 8 * (fq >> 1);
        const float* bg = bgu + (size_t)u.e * 2048 + col0;
        f32x4 bgv[2], buv[2];
#pragma unroll
        for (int n = 0; n < 2; ++n) { bgv[n] = *(const f32x4*)(bg + 4 * n); buv[n] = *(const f32x4*)(bg + 1024 + 4 * n); }
        float rsv[2][4]; const int cnt = ecnt[u.e];
#pragma unroll
        for (int ai = 0; ai < 2; ++ai)
#pragma unroll
            for (int m = 0; m < 4; ++m) { const int pos = u.mt * BM + ai * HALF + wr * 64 + m * 16 + fr; rsv[ai][m] = rstds[(size_t)u.e * ECAP + (pos < cnt ? pos : 0)]; }
        asm volatile("" : "+v"(rsv[0][0]), "+v"(rsv[0][1]), "+v"(rsv[0][2]), "+v"(rsv[0][3]), "+v"(rsv[1][0]), "+v"(rsv[1][1]), "+v"(rsv[1][2]), "+v"(rsv[1][3]));
        unsigned char* const sp = mid + (size_t)(u.pm * BM + wr * 64 + fr + 16 * (fq >> 1)) * 1024 + u.pn * HALF + wc * 32 + 16 * (fq & 1);
#pragma unroll
        for (int ai = 0; ai < 2; ++ai)
#pragma unroll
            for (int mp = 0; mp < 2; ++mp) { u32x2 w[2];
#pragma unroll
                for (int mm = 0; mm < 2; ++mm) { const int m = 2 * mp + mm; f32x4 o[2];
                    const float rs = rsv[ai][m];
#pragma unroll
                    for (int n = 0; n < 2; ++n) { const f32x4 g = acc[ai][0][m][n] * rs + bgv[n], uu = acc[ai][1][m][n] * rs + buv[n];
#pragma unroll
                        for (int e2 = 0; e2 < 2; ++e2) {
                            f32x2 gg = {fminf(g[2 * e2], 7.0f), fminf(g[2 * e2 + 1], 7.0f)};
                            f32x2 uc = {__builtin_amdgcn_fmed3f(uu[2 * e2], -7.0f, 7.0f), __builtin_amdgcn_fmed3f(uu[2 * e2 + 1], -7.0f, 7.0f)};
                            const f32x2 ea = gg * (-1.702f * LOG2E);
                            f32x2 ex = {__builtin_amdgcn_exp2f(ea.x), __builtin_amdgcn_exp2f(ea.y)};
                            const f32x2 dn = ex + 1.0f;
                            f32x2 rc = {__builtin_amdgcn_rcpf(dn.x), __builtin_amdgcn_rcpf(dn.y)};
                            const f32x2 r2 = (uc * SC_MID + SC_MID) * (gg * rc);
                            o[n][2 * e2] = r2.x; o[n][2 * e2 + 1] = r2.y; } }
                    w[mm].x = pk4_fp8(o[0][0], o[0][1], o[0][2], o[0][3]); w[mm].y = pk4_fp8(o[1][0], o[1][1], o[1][2], o[1][3]); }
                EPST(sp + (size_t)(ai * HALF + mp * 32) * 1024, pair_rows(w[0], w[1])); }
    }
};
struct EpiDown {
    static constexpr int PERM = 2; static constexpr int MIDT = 0, NST = 8;
    const float* bd; const float* rgate; unsigned char* Y; const LAS int* ecnt;
    __device__ __forceinline__ void operator()(AccRef acc, const Unit& u, int wr, int wc, int fr, int fq) const {
        const int col0 = u.pn * BM + wc * 32 + 16 * (fq & 1) + 8 * (fq >> 1), cnt = ecnt[u.e];
        f32x4 bv[2][2];
#pragma unroll
        for (int bj = 0; bj < 2; ++bj)
#pragma unroll
            for (int n = 0; n < 2; ++n) bv[bj][n] = *(const f32x4*)(bd + (size_t)u.e * 1024 + col0 + bj * HALF + 4 * n);
        float wv[2][4];
#pragma unroll
        for (int ai = 0; ai < 2; ++ai)
#pragma unroll
            for (int m = 0; m < 4; ++m) { const int pos = u.mt * BM + ai * HALF + wr * 64 + m * 16 + fr; const float t = rgate[(size_t)u.e * ECAP + (pos < cnt ? pos : 0)]; wv[ai][m] = pos < cnt ? t * SC_Y : 0.f; }
        unsigned char* const sp = Y + (size_t)(u.pm * BM + wr * 64 + fr + 16 * (fq >> 1)) * 1024 + u.pn * BM + wc * 32 + 16 * (fq & 1);
#pragma unroll
        for (int ai = 0; ai < 2; ++ai)
#pragma unroll
            for (int mp = 0; mp < 2; ++mp)
#pragma unroll
                for (int bj = 0; bj < 2; ++bj) { u32x2 o[2];
#pragma unroll
                    for (int mm = 0; mm < 2; ++mm) { const int m = 2 * mp + mm; const float w = wv[ai][m];
                        const f32x4 v0 = (acc[ai][bj][m][0] + bv[bj][0]) * w, v1 = (acc[ai][bj][m][1] + bv[bj][1]) * w;
                        o[mm].x = pk4_fp8s(v0[0], v0[1], v0[2], v0[3]); o[mm].y = pk4_fp8s(v1[0], v1[1], v1[2], v1[3]); }
                    EPST(sp + (size_t)(ai * HALF + mp * 32) * 1024 + bj * HALF, pair_rows(o[0], o[1])); }
    }
};
}

namespace att {
using bf16 = __hip_bfloat16;
constexpr int NW = 8, QBLK = 32, QB = QBLK * NW, KVBLK = 64;
__device__ __forceinline__ int crow(int r, int hi) { return (r & 3) + 8 * (r >> 2) + 4 * hi; }
__device__ __forceinline__ f32x16 splat16(float z) { return (f32x16){z, z, z, z, z, z, z, z, z, z, z, z, z, z, z, z}; }
#define SBAR() __builtin_amdgcn_sched_barrier(0)
__device__ __forceinline__ void cmask(f32x16& p0, f32x16& p1, int jb, int qrel, int hi) {
    const float NEG = -INFINITY; int kb = 64 * jb + 4 * hi;
#pragma unroll
    for (int r = 0; r < 16; ++r) { int kv = kb + (r & 3) + 8 * (r >> 2); if (kv > qrel) p0[r] = NEG; if (kv + 32 > qrel) p1[r] = NEG; }
}
constexpr int NSLOT = 3, SLOTB = 8192;
constexpr int LDS_K = 0, LDS_V = NSLOT * SLOTB, LDS_WS = 2 * NSLOT * SLOTB, LDS_OST = LDS_WS + NW * 64 * 4, LDS_KB = LDS_OST + NW * 4096, LDS_T0 = LDS_KB + SEQ * 4, LDS_BYTES = LDS_T0 + 16;
__device__ __forceinline__ void glds16(const void* gsrc, unsigned lds_dst) { unsigned keep;
    asm volatile("s_mov_b32 %0, m0\n\ts_mov_b32 m0, %2\n\ts_nop 0\n\tglobal_load_lds_dwordx4 %1, off\n\ts_mov_b32 m0, %0" : "=&s"(keep) : "v"(gsrc), "s"(lds_dst) : "memory"); }
__device__ __forceinline__ float max3f(float a, float b, float c) { float r; asm("v_max3_f32 %0, %1, %2, %3" : "=v"(r) : "v"(a), "v"(b), "v"(c)); return r; }
__device__ __forceinline__ float max2f(float a, float b) { float r; asm("v_max_f32_e32 %0, %1, %2" : "=v"(r) : "v"(a), "v"(b)); return r; }
__device__ __forceinline__ float fadd_s(float a, float b) { float r; asm("v_add_f32_e32 %0, %1, %2" : "=v"(r) : "v"(a), "v"(b)); return r; }
__device__ __forceinline__ float fsub_s(float a, float b) { float r; asm("v_sub_f32_e32 %0, %1, %2" : "=v"(r) : "v"(a), "v"(b)); return r; }
typedef __bf16 bf16x2_t __attribute__((ext_vector_type(2)));
__device__ __forceinline__ unsigned cvtpk_s(float lo, float hi) { f32x2 v = {lo, hi}; bf16x2_t b = __builtin_convertvector(v, bf16x2_t); return __builtin_bit_cast(unsigned, b); }
#define WAIT_BAR(N) asm volatile("s_waitcnt vmcnt(" #N ") lgkmcnt(0)\n\ts_barrier" ::: "memory")
__device__ __forceinline__ void qkt(f32x16& p0, f32x16& p1, const char* Kslot, const bf16x8* qr, const f32x16& cinit, int r32, int hi) {
    const char* kb = Kslot + hi * 1024 + r32 * 16;
#pragma unroll
    for (int d0 = 0; d0 < 4; ++d0) {
        const bf16x8 b0 = *reinterpret_cast<const bf16x8*>(kb + d0 * 2048);
        const bf16x8 b1 = *reinterpret_cast<const bf16x8*>(kb + d0 * 2048 + 512);
        if (d0 == 0) { p0 = __builtin_amdgcn_mfma_f32_32x32x16_bf16(b0, qr[0], cinit, 0, 0, 0); p1 = __builtin_amdgcn_mfma_f32_32x32x16_bf16(b1, qr[0], cinit, 0, 0, 0); }
        else { p0 = __builtin_amdgcn_mfma_f32_32x32x16_bf16(b0, qr[d0], p0, 0, 0, 0); p1 = __builtin_amdgcn_mfma_f32_32x32x16_bf16(b1, qr[d0], p1, 0, 0, 0); } }
}
typedef LAS const char* lds_cptr;
typedef short v4i16_t __attribute__((ext_vector_type(4)));
__device__ __forceinline__ void kload8(bf16x8* kf, lds_cptr kp) {
    kf[0] = *(const LAS bf16x8*)(kp);        kf[1] = *(const LAS bf16x8*)(kp + 512);
    kf[2] = *(const LAS bf16x8*)(kp + 2048); kf[3] = *(const LAS bf16x8*)(kp + 2560);
    kf[4] = *(const LAS bf16x8*)(kp + 4096); kf[5] = *(const LAS bf16x8*)(kp + 4608);
    kf[6] = *(const LAS bf16x8*)(kp + 6144); kf[7] = *(const LAS bf16x8*)(kp + 6656);
}
__device__ __forceinline__ void kload2(bf16x8* kf, lds_cptr kp, int j) { kf[2 * j] = *(const LAS bf16x8*)(kp + j * 2048); kf[2 * j + 1] = *(const LAS bf16x8*)(kp + j * 2048 + 512); }
__device__ __forceinline__ s16x4 vtr(lds_cptr p) { return __builtin_bit_cast(s16x4, __builtin_amdgcn_ds_read_tr16_b64_v4i16((LAS v4i16_t*)p)); }
__device__ __forceinline__ float rowmax(const f32x16& p0, const f32x16& p1) {
    float a = max3f(p0[0], p0[1], p1[0]), b = max3f(p0[2], p0[3], p1[1]); a = max3f(a, p1[2], p1[3]);
#pragma unroll
    for (int r = 4; r < 16; r += 4) { a = max3f(a, p0[r], p0[r + 1]); b = max3f(b, p0[r + 2], p0[r + 3]); a = max3f(a, p1[r], p1[r + 1]); b = max3f(b, p1[r + 2], p1[r + 3]); }
    const float m = max2f(a, b);
    auto rr = __builtin_amdgcn_permlane32_swap(__float_as_uint(m), __float_as_uint(m), false, false);
    return max2f(__uint_as_float(rr[0]), __uint_as_float(rr[1]));
}
__device__ __forceinline__ void pv(f32x16* o, int vb, bf16x8 pa0, bf16x8 pa1, bf16x8 pa2, bf16x8 pa3) {
#pragma unroll
    for (int d0 = 0; d0 < 2; ++d0) { s16x4 lo[4], hi[4];
#pragma unroll
        for (int ks = 0; ks < 4; ++ks) {
            asm volatile("ds_read_b64_tr_b16 %0,%1 offset:%c2" : "=&v"(lo[ks]) : "v"(vb), "i"(d0 * 4096 + ks * 1024) : "memory");
            asm volatile("ds_read_b64_tr_b16 %0,%1 offset:%c2" : "=&v"(hi[ks]) : "v"(vb), "i"(d0 * 4096 + ks * 1024 + 512) : "memory"); }
        asm volatile("s_waitcnt lgkmcnt(0)" ::: "memory"); SBAR();
#define PK(k) (bf16x8){lo[k][0], lo[k][1], lo[k][2], lo[k][3], hi[k][0], hi[k][1], hi[k][2], hi[k][3]}
        o[d0] = __builtin_amdgcn_mfma_f32_32x32x16_bf16(pa0, PK(0), o[d0], 0, 0, 0);
        o[d0] = __builtin_amdgcn_mfma_f32_32x32x16_bf16(pa1, PK(1), o[d0], 0, 0, 0);
        o[d0] = __builtin_amdgcn_mfma_f32_32x32x16_bf16(pa2, PK(2), o[d0], 0, 0, 0);
        o[d0] = __builtin_amdgcn_mfma_f32_32x32x16_bf16(pa3, PK(3), o[d0], 0, 0, 0);
#undef PK
    }
}
#define KADD(C0, C1, t) do { const LAS f32x4* kp_ = (const LAS f32x4*)(kbl + 64 * (t) + 4 * hi); \
    _Pragma("unroll") for (int j_ = 0; j_ < 4; ++j_) { const f32x4 a_ = kp_[2 * j_] - mhat, b_ = kp_[8 + 2 * j_] - mhat; \
      C0[4 * j_] += a_[0]; C0[4 * j_ + 1] += a_[1]; C0[4 * j_ + 2] += a_[2]; C0[4 * j_ + 3] += a_[3]; \
      C1[4 * j_] += b_[0]; C1[4 * j_ + 1] += b_[1]; C1[4 * j_ + 2] += b_[2]; C1[4 * j_ + 3] += b_[3]; } } while (0)

template <int THRL> __device__ __forceinline__ void fox_unit(int b, int h, int qb, const bf16* Q, const bf16* __restrict__ K, const bf16* __restrict__ V, bf16* O, const float* cbl, float Tthr, char* shm) {
    constexpr int PIT = BW;
    int tid = threadIdx.x; asm volatile("" : "+v"(tid));
    float zf = 0.f; asm volatile("" : "+v"(zf));
    const int lane = tid & 63, r32 = lane & 31, hi = lane >> 5; const int wid = __builtin_amdgcn_readfirstlane(tid >> 6);
    const long rowbase = (long)b * SEQ; const int q0 = qb * QB;
    const bf16* Qw = Q + (rowbase + q0 + wid * QBLK) * PIT + h * 64;
    const bf16* Kh = K + rowbase * PIT + h * 64, *Vh = V + rowbase * PIT + h * 64;
    const unsigned lds0 = (unsigned)(uintptr_t)shm;
    float* wsf = (float*)(shm + LDS_WS) + wid * 64;
    const LAS float* kbl = (const LAS float*)((lds_cptr)shm + LDS_KB);
    const bf16* ksrc = Kh + (long)lane * PIT + wid * 8;
    const bf16* vsrc = Vh + (long)(16 * (wid & 3) + (lane >> 2)) * PIT + (wid >> 2) * 32 + (lane & 3) * 8;
    int NT = (q0 + QB) / KVBLK;
    const unsigned kdst = lds0 + LDS_K + wid * 1024, vdst = lds0 + LDS_V + wid * 1024;
#define DMA_K(t, slot) glds16(ksrc + (long)(t) * KVBLK * PIT, (unsigned)__builtin_amdgcn_readfirstlane(kdst + (slot)))
#define DMA_V(t, slot) glds16(vsrc + (long)(t) * KVBLK * PIT, (unsigned)__builtin_amdgcn_readfirstlane(vdst + (slot)))
    const int vb0 = (int)(lds0 + LDS_V) + ((lane >> 4) & 1) * 32 + (lane & 3) * 8 + (4 * hi + ((lane & 15) >> 2)) * 64;
    const char* Kbase = shm + LDS_K; bf16x8 kf[8];
    const lds_cptr shm3 = (lds_cptr)shm; const lds_cptr kp0 = shm3 + LDS_K + hi * 1024 + r32 * 16; const lds_cptr vp0 = shm3 + LDS_V + ((lane >> 4) & 1) * 32 + (lane & 3) * 8 + (4 * hi + ((lane & 15) >> 2)) * 64;
    { const float* cb = cbl + (size_t)(b * 8 + h) * SEQ; LAS float* kw = (LAS float*)((lds_cptr)shm + LDS_KB); const int nmax = q0 + QB;
      const float cref = cb[q0]; const float c63 = cb[64 * (lane < NT ? lane : NT - 1) + 63];
      float tv[8];
#pragma unroll
      for (int i = 0; i < 8; ++i) { const int sidx = tid + NW * 64 * i; tv[i] = cb[sidx < nmax ? sidx : nmax - 1]; }
      const bool skip = (lane < NT) && (cref - c63 <= -Tthr);
      int ts = (int)__popcll(__ballot(skip)) & ~1; ts = ts < NT - 4 ? ts : NT - 4;
      const int t0 = __builtin_amdgcn_readfirstlane(ts);
      ksrc += (long)t0 * KVBLK * PIT; vsrc += (long)t0 * KVBLK * PIT; kbl += 64 * t0; NT -= t0;
      DMA_K(0, 0); DMA_V(0, 0); DMA_K(1, SLOTB);
#pragma unroll
      for (int i = 0; i < 8; ++i) { const int sidx = tid + NW * 64 * i; if (sidx < nmax) kw[sidx] = cref - tv[i]; } }
    bf16x8 qr[4];
#pragma unroll
    for (int d0 = 0; d0 < 4; ++d0) qr[d0] = *reinterpret_cast<const bf16x8*>(&Qw[(long)r32 * PIT + d0 * 16 + hi * 8]);
    float mhat = zf, l_reg = zf; f32x16 o[2]; o[0] = splat16(zf); o[1] = splat16(zf); const f32x16 zero16 = splat16(0.f);
    const int qrel = wid * QBLK + r32;
#define CMASK(P0, P1, t) do { int jb_ = (t) - (NT - 4); if (jb_ >= 0) cmask(P0, P1, jb_, qrel, hi); } while (0)
    bool resc = false;
#define START(P0, P1) do { const float rm = rowmax(P0, P1); resc = false; \
    { const float dl = rm; mhat = fadd_s(mhat, dl); \
      _Pragma("unroll") for (int r = 0; r < 16; ++r) { P0[r] = fsub_s(P0[r], dl); P1[r] = fsub_s(P1[r], dl); } } \
    _Pragma("unroll") for (int r = 0; r < 16; ++r) P0[r] = __builtin_amdgcn_exp2f(P0[r]); } while (0)
#define RESC() do { if (resc) { asm volatile("s_waitcnt lgkmcnt(0)" ::: "memory"); \
      _Pragma("unroll") for (int d_ = 0; d_ < 2; ++d_) _Pragma("unroll") for (int r = 0; r < 16; ++r) o[d_][r] *= wsf[crow(r, hi)]; } } while (0)
    f32x16 pA0, pA1, pB0, pB1;
    int sl_prev = 0, sl_cur = 0, sl_next = SLOTB;
#define ROT() do { sl_prev = sl_cur; sl_cur = sl_next; sl_next = (sl_next == (NSLOT - 1) * SLOTB) ? 0 : sl_next + SLOTB; } while (0)
    DMA_K(2, 2 * SLOTB);
    WAIT_BAR(3);
    qkt(pA0, pA1, Kbase, qr, zero16, r32, hi); KADD(pA0, pA1, 0); asm volatile("s_nop 15\n\ts_nop 7" : "+v"(pA0), "+v"(pA1)); CMASK(pA0, pA1, 0);
    START(pA0, pA1);
    _Pragma("unroll") for (int r = 0; r < 16; ++r) pA1[r] = __builtin_amdgcn_exp2f(pA1[r]);
    WAIT_BAR(0);
    DMA_K(3, 0); DMA_V(1, SLOTB);
    ROT();
    kload8(kf, kp0 + sl_cur);
    WAIT_BAR(2);
    s16x4 vlo[8], vhi[8]; u32x4 pw0, pw1, pw2, pw3;
#define PKW(P, B) cvtpk_s(P[B], P[B + 1])
#define PAF(k) __builtin_bit_cast(bf16x8, pw##k)
#define VFR(i) (bf16x8){vlo[i][0], vlo[i][1], vlo[i][2], vlo[i][3], vhi[i][0], vhi[i][1], vhi[i][2], vhi[i][3]}
#define PIN(x) asm volatile("" : "+v"(x))
#define MX3(a, b, c) __builtin_fmaxf(__builtin_fmaxf((a), (b)), (c))
#define GAPA(MF, A0, A1, A2, A3, W0, W1, PW) do { MF; sacc += A0; sacc += A1; sacc += A2; sacc += A3; PIN(sacc); W0; W1; PIN(PW); SBAR(); } while (0)
#define EX(v) __builtin_amdgcn_exp2f(v)
#define GAPB(MF, X, B) do { MF; X[B] = EX(X[B]); X[B + 1] = EX(X[B + 1]); X[B + 2] = EX(X[B + 2]); X[B + 3] = EX(X[B + 3]); PIN(X); SBAR(); } while (0)
#define VRD(i) do { vlo[i] = vtr(vp_ + (((i) >> 2) * 4096 + ((i) & 3) * 1024)); vhi[i] = vtr(vp_ + (((i) >> 2) * 4096 + ((i) & 3) * 1024 + 512)); } while (0)
#define KRD(G, j) do { if (G) { kload2(kf, kp0 + sl_next, j); SBAR(); } } while (0)
#define STEP(C0, C1, P0, P1, t, GK, GV, GL) do { SBAR(); \
    const lds_cptr vp_ = vp0 + sl_prev; \
    VRD(0); SBAR(); float sacc = (P0[0] + P0[1]); \
    GAPA(C0 = __builtin_amdgcn_mfma_f32_32x32x16_bf16(kf[0], qr[0], zero16, 0, 0, 0), P0[2], P0[3], P0[4], P0[5],     pw0[0] = PKW(P0, 0), pw0[1] = PKW(P0, 2), pw0); \
    VRD(4); SBAR(); GAPA(C1 = __builtin_amdgcn_mfma_f32_32x32x16_bf16(kf[1], qr[0], zero16, 0, 0, 0), P0[6], P0[7], P0[8], P0[9],     pw0[2] = PKW(P0, 4), pw0[3] = PKW(P0, 6), pw0); \
    VRD(1); SBAR(); GAPA(C0 = __builtin_amdgcn_mfma_f32_32x32x16_bf16(kf[2], qr[1], C0, 0, 0, 0),   P0[10], P0[11], P0[12], P0[13], pw1[0] = PKW(P0, 8), pw1[1] = PKW(P0, 10), pw1); \
    VRD(5); SBAR(); GAPA(C1 = __builtin_amdgcn_mfma_f32_32x32x16_bf16(kf[3], qr[1], C1, 0, 0, 0),   P0[14], P0[15], P1[0], P1[1],   pw1[2] = PKW(P0, 12), pw1[3] = PKW(P0, 14), pw1); \
    VRD(2); SBAR(); GAPA(C0 = __builtin_amdgcn_mfma_f32_32x32x16_bf16(kf[4], qr[2], C0, 0, 0, 0),   P1[2], P1[3], P1[4], P1[5],     pw2[0] = PKW(P1, 0), pw2[1] = PKW(P1, 2), pw2); \
    VRD(6); SBAR(); GAPA(C1 = __builtin_amdgcn_mfma_f32_32x32x16_bf16(kf[5], qr[2], C1, 0, 0, 0),   P1[6], P1[7], P1[8], P1[9],     pw2[2] = PKW(P1, 4), pw2[3] = PKW(P1, 6), pw2); \
    VRD(3); SBAR(); GAPA(C0 = __builtin_amdgcn_mfma_f32_32x32x16_bf16(kf[6], qr[3], C0, 0, 0, 0),   P1[10], P1[11], P1[12], P1[13], pw3[0] = PKW(P1, 8), pw3[1] = PKW(P1, 10), pw3); \
    VRD(7); SBAR(); GAPA(C1 = __builtin_amdgcn_mfma_f32_32x32x16_bf16(kf[7], qr[3], C1, 0, 0, 0),   P1[14], P1[15], 0.f, 0.f,       pw3[2] = PKW(P1, 12), pw3[3] = PKW(P1, 14), pw3); \
    l_reg += sacc; \
    if (GK) { DMA_K((t) + 3, sl_cur); } if (GV) { DMA_V((t) + 1, sl_next); } \
    KADD(C0, C1, t); \
    CMASK(C0, C1, t); \
    { float a = MX3(C0[0], C0[1], C1[0]), b = MX3(C0[2], C0[3], C1[1]); a = MX3(a, C1[2], C1[3]); \
      _Pragma("unroll") for (int r = 4; r < 16; r += 4) { a = MX3(a, C0[r], C0[r + 1]); b = MX3(b, C0[r + 2], C0[r + 3]); a = MX3(a, C1[r], C1[r + 1]); b = MX3(b, C1[r + 2], C1[r + 3]); } \
      float rm = __builtin_fmaxf(a, b); { auto rr = __builtin_amdgcn_permlane32_swap(__float_as_uint(rm), __float_as_uint(rm), false, false); rm = __builtin_fmaxf(__uint_as_float(rr[0]), __uint_as_float(rr[1])); } \
      resc = false; \
      if (__builtin_expect(__any(rm > (float)THRL), 0)) { const float dl = __builtin_fmaxf(rm, 0.f); mhat += dl; \
        _Pragma("unroll") for (int r = 0; r < 16; ++r) { C0[r] -= dl; C1[r] -= dl; } \
        const float f = __builtin_amdgcn_exp2f(-dl); l_reg *= f; if (hi == 0) wsf[r32] = f; resc = true; } } \
    SBAR(); \
    GAPB(o[0] = __builtin_amdgcn_mfma_f32_32x32x16_bf16(PAF(0), VFR(0), o[0], 0, 0, 0), C0, 0); \
    GAPB(o[1] = __builtin_amdgcn_mfma_f32_32x32x16_bf16(PAF(0), VFR(4), o[1], 0, 0, 0), C0, 4); \
    KRD(GL, 0); GAPB(o[0] = __builtin_amdgcn_mfma_f32_32x32x16_bf16(PAF(1), VFR(1), o[0], 0, 0, 0), C0, 8); \
    KRD(GL, 1); GAPB(o[1] = __builtin_amdgcn_mfma_f32_32x32x16_bf16(PAF(1), VFR(5), o[1], 0, 0, 0), C0, 12); \
    KRD(GL, 2); GAPB(o[0] = __builtin_amdgcn_mfma_f32_32x32x16_bf16(PAF(2), VFR(2), o[0], 0, 0, 0), C1, 0); \
    KRD(GL, 3); GAPB(o[1] = __builtin_amdgcn_mfma_f32_32x32x16_bf16(PAF(2), VFR(6), o[1], 0, 0, 0), C1, 4); \
    GAPB(o[0] = __builtin_amdgcn_mfma_f32_32x32x16_bf16(PAF(3), VFR(3), o[0], 0, 0, 0), C1, 8); \
    GAPB(o[1] = __builtin_amdgcn_mfma_f32_32x32x16_bf16(PAF(3), VFR(7), o[1], 0, 0, 0), C1, 12); \
    } while (0)
    int t = 1;
#undef CMASK
#define CMASK(P0, P1, t) do {} while (0)
    for (; t + 5 < NT; t += 2) {
        STEP(pB0, pB1, pA0, pA1, t, true, true, true);     WAIT_BAR(2); RESC(); ROT();
        STEP(pA0, pA1, pB0, pB1, t + 1, true, true, true); WAIT_BAR(2); RESC(); ROT();
    }
#undef CMASK
#define CMASK(P0, P1, t) do { int jb_ = (t) - (NT - 4); if (jb_ >= 0) cmask(P0, P1, jb_, qrel, hi); } while (0)
#define ENDW(tt) do { if ((tt) + 3 < NT) { WAIT_BAR(2); } else if ((tt) + 2 < NT) { WAIT_BAR(1); } else { WAIT_BAR(0); } } while (0)
    for (; t + 1 < NT; t += 2) {
        STEP(pB0, pB1, pA0, pA1, t, (t + 3 < NT), (t + 1 < NT), (t + 1 < NT));         ENDW(t);     RESC(); ROT();
        STEP(pA0, pA1, pB0, pB1, t + 1, (t + 4 < NT), (t + 2 < NT), (t + 2 < NT));     ENDW(t + 1); RESC(); ROT();
    }
    STEP(pB0, pB1, pA0, pA1, NT - 1, false, false, false); RESC();
    { float sacc = pB0[0] + pB0[1]; _Pragma("unroll") for (int r = 2; r < 16; ++r) sacc += pB0[r]; _Pragma("unroll") for (int r = 0; r < 16; ++r) sacc += pB1[r]; l_reg += sacc;
      pw0 = (u32x4){PKW(pB0, 0), PKW(pB0, 2), PKW(pB0, 4), PKW(pB0, 6)}; pw1 = (u32x4){PKW(pB0, 8), PKW(pB0, 10), PKW(pB0, 12), PKW(pB0, 14)}; pw2 = (u32x4){PKW(pB1, 0), PKW(pB1, 2), PKW(pB1, 4), PKW(pB1, 6)}; pw3 = (u32x4){PKW(pB1, 8), PKW(pB1, 10), PKW(pB1, 12), PKW(pB1, 14)};
      SBAR(); pv(o, vb0 + sl_cur, PAF(0), PAF(1), PAF(2), PAF(3)); }
#undef GAPA
#undef GAPB
#undef EX
#undef VRD
#undef KRD
#undef STEP
#undef ENDW
    { auto rr = __builtin_amdgcn_permlane32_swap(__float_as_uint(l_reg), __float_as_uint(l_reg), false, false); l_reg = __uint_as_float(rr[0]) + __uint_as_float(rr[1]); }
    if (hi == 0) wsf[32 + r32] = l_reg; asm volatile("s_waitcnt lgkmcnt(0)" ::: "memory");
    float rli[16];
#pragma unroll
    for (int r = 0; r < 16; ++r) rli[r] = __builtin_amdgcn_rcpf(wsf[32 + crow(r, hi)]);
    bf16* Ow = O + (rowbase + q0 + wid * QBLK) * OABP + OAW + h * 64;
    { bf16* stg = (bf16*)(shm + LDS_OST) + wid * 2048;
#pragma unroll
      for (int r = 0; r < 16; ++r) { const int orow = crow(r, hi);
#pragma unroll
          for (int d0 = 0; d0 < 2; ++d0) stg[orow * 64 + d0 * 32 + r32] = __float2bfloat16(o[d0][r] * rli[r]); }
      asm volatile("s_waitcnt lgkmcnt(0)" ::: "memory");
#pragma unroll
      for (int i = 0; i < 4; ++i) { const int row = i * 8 + (lane >> 3), ch = lane & 7; const u32x4 v = *(const u32x4*)(stg + row * 64 + ch * 8); *(u32x4*)(Ow + (long)row * OABP + ch * 8) = v; } }
    asm volatile("s_waitcnt lgkmcnt(0)\n\ts_barrier" ::: "memory");
#undef DMA_K
#undef DMA_V
#undef CMASK
#undef START
#undef RESC
#undef ROT
}

constexpr int DS_K = 0, DS_V = 6 * SLOTB, DS_OST = 12 * SLOTB;
__device__ const unsigned char T5_BUCKET[3][129] = {
 {0,1,2,3,4,5,6,7,8,9,10,11,12,13,14,15,16,16,16,16,16,16,17,17,17,17,17,17,17,17,18,18,18,18,18,18,18,18,18,18,19,19,19,19,19,19,19,19,19,19,19,19,19,19,20,20,20,20,20,20,20,20,20,20,20,20,20,20,20,20,20,20,20,21,21,21,21,21,21,21,21,21,21,21,21,21,21,21,21,21,21,21,21,21,21,21,21,21,21,22,22,22,22,22,22,22,22,22,22,22,22,22,22,22,22,22,22,22,22,22,22,22,22,22,22,22,22,22,22},
 {0,4,8,12,16,16,17,17,18,18,19,19,19,19,20,20,20,20,20,21,21,21,21,21,21,22,22,22,22,22,22,22,22,22,23,23,23,23,23,23,23,23,23,23,23,23,24,24,24,24,24,24,24,24,24,24,24,24,24,24,24,24,25,25,25,25,25,25,25,25,25,25,25,25,25,25,25,25,25,25,25,25,25,26,26,26,26,26,26,26,26,26,26,26,26,26,26,26,26,26,26,26,26,26,26,26,26,26,26,26,26,26,26,27,27,27,27,27,27,27,27,27,27,27,27,27,27,27,27},
 {0,16,18,19,20,21,21,22,22,23,23,23,24,24,24,24,25,25,25,25,25,26,26,26,26,26,26,26,26,27,27,27,27,27,27,27,27,27,27,28,28,28,28,28,28,28,28,28,28,28,28,28,29,29,29,29,29,29,29,29,29,29,29,29,29,29,29,29,29,29,30,30,30,30,30,30,30,30,30,30,30,30,30,30,30,30,30,30,30,30,30,30,30,30,30,31,31,31,31,31,31,31,31,31,31,31,31,31,31,31,31,31,31,31,31,31,31,31,31,31,31,31,31,31,31,31,31,31,31}};
__device__ __forceinline__ void dswa_unit(int b, int g, int hg, int rres, int qb, const bf16* Q, const bf16* __restrict__ K, const bf16* __restrict__ V, bf16* Og, float* lse, const float* rel_bias,
                                          char* shm, LAS float* lut, LAS float* wsfb) {
    constexpr int PIT = AW;
    int tid = threadIdx.x; asm volatile("" : "+v"(tid));
    float zf = 0.f; asm volatile("" : "+v"(zf));
    const int lane = tid & 63, r32 = lane & 31, hi = lane >> 5; const int wid = __builtin_amdgcn_readfirstlane(tid >> 6);
    const int dsh = 2 * g, d = 1 << dsh, head = g * 4 + hg;
    const long tok0 = (long)b * SEQ + rres;
    const int kstart = 256 * qb - 128;
    const unsigned lds0 = (unsigned)(uintptr_t)shm;
    {
        const bf16* Kh = K + head * 64 + wid * 8;
        const bf16* Vh = V + head * 64 + (wid >> 2) * 32 + (lane & 3) * 8;
#pragma unroll
        for (int j = 0; j < 6; ++j) {
            int mk = kstart + 64 * j + lane; mk = mk < 0 ? 0 : mk;
            int mv = kstart + 64 * j + 16 * (wid & 3) + (lane >> 2); mv = mv < 0 ? 0 : mv;
            glds16(Kh + (tok0 + (long)d * mk) * PIT, (unsigned)__builtin_amdgcn_readfirstlane(lds0 + DS_K + j * SLOTB + wid * 1024));
            glds16(Vh + (tok0 + (long)d * mv) * PIT, (unsigned)__builtin_amdgcn_readfirstlane(lds0 + DS_V + j * SLOTB + wid * 1024));
        }
    }
    if (tid < 256) { const int back = tid - 64; float v = -INFINITY; if (back >= 0 && back <= 128) v = rel_bias[(int)T5_BUCKET[g][back] * 12 + head] * LOG2E; lut[tid] = v; }
    const int mq0 = 256 * qb + 32 * wid;
    const bf16* Qw = Q + (tok0 + (long)d * (mq0 + r32)) * PIT + head * 64;
    bf16x8 qr[4];
#pragma unroll
    for (int d0 = 0; d0 < 4; ++d0) qr[d0] = *reinterpret_cast<const bf16x8*>(&Qw[d0 * 16 + hi * 8]);
    asm volatile("s_waitcnt vmcnt(0) lgkmcnt(0)" ::: "memory"); __syncthreads();
    const int j0 = wid >> 1;
    f32x16 p[6]; const f32x16 zero16 = splat16(zf);
#pragma unroll
    for (int jj = 0; jj < 3; ++jj) { qkt(p[2 * jj], p[2 * jj + 1], shm + DS_K + (j0 + jj) * SLOTB, qr, zero16, r32, hi); }
    const int ib = 192 + 32 * (wid & 1) + r32 - 4 * hi;
    if (qb == 0) {
#pragma unroll
        for (int jj = 0; jj < 3; ++jj) if (j0 + jj < 2) { p[2 * jj] = splat16(-INFINITY); p[2 * jj + 1] = splat16(-INFINITY); }
    }
    float mx = -INFINITY;
#pragma unroll
    for (int jj = 0; jj < 3; ++jj)
#pragma unroll
        for (int sub = 0; sub < 2; ++sub)
#pragma unroll
            for (int r = 0; r < 16; ++r) {
                const int cr = (r & 3) + 8 * (r >> 2);
                const float s = p[2 * jj + sub][r] + lut[ib - 64 * jj - 32 * sub - cr];
                p[2 * jj + sub][r] = s; mx = fmaxf(mx, s);
            }
    { auto rr = __builtin_amdgcn_permlane32_swap(__float_as_uint(mx), __float_as_uint(mx), false, false); mx = fmaxf(__uint_as_float(rr[0]), __uint_as_float(rr[1])); }
    float l = 0.f;
#pragma unroll
    for (int t = 0; t < 6; ++t)
#pragma unroll
        for (int r = 0; r < 16; ++r) { const float e = __builtin_amdgcn_exp2f(p[t][r] - mx); p[t][r] = e; l += e; }
    { auto rr = __builtin_amdgcn_permlane32_swap(__float_as_uint(l), __float_as_uint(l), false, false); l = __uint_as_float(rr[0]) + __uint_as_float(rr[1]); }
    f32x16 o[2]; o[0] = splat16(zf); o[1] = splat16(zf);
    const int vb0 = (int)(lds0 + DS_V) + ((lane >> 4) & 1) * 32 + (lane & 3) * 8 + (4 * hi + ((lane & 15) >> 2)) * 64;
#pragma unroll
    for (int jj = 0; jj < 3; ++jj) {
        const f32x16& P0 = p[2 * jj]; const f32x16& P1 = p[2 * jj + 1];
        const u32x4 w0 = (u32x4){cvtpk_s(P0[0], P0[1]), cvtpk_s(P0[2], P0[3]), cvtpk_s(P0[4], P0[5]), cvtpk_s(P0[6], P0[7])};
        const u32x4 w1 = (u32x4){cvtpk_s(P0[8], P0[9]), cvtpk_s(P0[10], P0[11]), cvtpk_s(P0[12], P0[13]), cvtpk_s(P0[14], P0[15])};
        const u32x4 w2 = (u32x4){cvtpk_s(P1[0], P1[1]), cvtpk_s(P1[2], P1[3]), cvtpk_s(P1[4], P1[5]), cvtpk_s(P1[6], P1[7])};
        const u32x4 w3 = (u32x4){cvtpk_s(P1[8], P1[9]), cvtpk_s(P1[10], P1[11]), cvtpk_s(P1[12], P1[13]), cvtpk_s(P1[14], P1[15])};
        pv(o, vb0 + (j0 + jj) * SLOTB, __builtin_bit_cast(bf16x8, w0), __builtin_bit_cast(bf16x8, w1), __builtin_bit_cast(bf16x8, w2), __builtin_bit_cast(bf16x8, w3));
    }
    LAS float* wsf = wsfb + wid * 64;
    if (hi == 0) { wsf[r32] = l; lse[(tok0 + (long)d * (mq0 + r32)) * 4 + hg] = mx + __log2f(l); }
    asm volatile("s_waitcnt lgkmcnt(0)" ::: "memory");
    float rli[16];
#pragma unroll
    for (int r = 0; r < 16; ++r) rli[r] = __builtin_amdgcn_rcpf(wsf[crow(r, hi)]);
    { bf16* stg = (bf16*)(shm + DS_OST) + wid * 2048;
#pragma unroll
      for (int r = 0; r < 16; ++r) { const int orow = crow(r, hi);
#pragma unroll
          for (int d0 = 0; d0 < 2; ++d0) stg[orow * 64 + d0 * 32 + r32] = __float2bfloat16(o[d0][r] * rli[r]); }
      asm volatile("s_waitcnt lgkmcnt(0)" ::: "memory");
#pragma unroll
      for (int i = 0; i < 4; ++i) { const int row = i * 8 + (lane >> 3), ch = lane & 7; const u32x4 v = *(const u32x4*)(stg + row * 64 + ch * 8);
          *(u32x4*)(Og + (tok0 + (long)d * (mq0 + row)) * OAW + hg * 64 + ch * 8) = v; } }
    asm volatile("s_waitcnt lgkmcnt(0)" ::: "memory"); __syncthreads();
}
#undef SBAR
#undef WAIT_BAR
#undef KADD
#undef PKW
#undef PAF
#undef VFR
#undef PIN
#undef MX3
}

constexpr int NWAVES = 8;
constexpr int N_LAUNCHES = MK_N_LAUNCHES;
constexpr int N_PHASES = 10;
struct Args { const float* in[20]; float* out; unsigned char* ws; int ph_lo, ph_hi, li, pad; };

struct TrItem { const float* src; unsigned char* dst; int ldn, ldkb; bool fp8; };
__device__ __forceinline__ void tr_load(const TrItem& d, f32x4 (&t)[8], int lane) {
    const int kq = lane >> 3, n4 = (lane & 7) * 4; const GAS float* src = (const GAS float*)(d.src + (size_t)kq * d.ldn + n4);
#pragma unroll
    for (int i = 0; i < 8; ++i) t[i] = __builtin_nontemporal_load((const GAS f32x4*)(src + (size_t)(8 * i) * d.ldn));
}
__device__ __forceinline__ void tr_store(const TrItem& d, const f32x4 (&t)[8], LAS float* scr, int lane) {
    { const int kq = lane >> 3, n4 = (lane & 7) * 4;
#pragma unroll
      for (int i = 0; i < 8; ++i) { LAS float* p = scr + (8 * i + kq) * 33 + n4; p[0] = t[i].x; p[1] = t[i].y; p[2] = t[i].z; p[3] = t[i].w; } }
    LDS_WAIT(); asm volatile("" ::: "memory");
    const int c = lane & 7;
    if (d.fp8) {
        const int c4 = lane & 3;
#pragma unroll
        for (int j = 0; j < 2; ++j) { const int n = (lane >> 2) + 16 * j; const LAS float* s = scr + (16 * c4) * 33 + n; u32x4 o;
            o.x = pk4_fp8(s[0 * 33] * SC_W, s[1 * 33] * SC_W, s[2 * 33] * SC_W, s[3 * 33] * SC_W); o.y = pk4_fp8(s[4 * 33] * SC_W, s[5 * 33] * SC_W, s[6 * 33] * SC_W, s[7 * 33] * SC_W);
            o.z = pk4_fp8(s[8 * 33] * SC_W, s[9 * 33] * SC_W, s[10 * 33] * SC_W, s[11 * 33] * SC_W); o.w = pk4_fp8(s[12 * 33] * SC_W, s[13 * 33] * SC_W, s[14 * 33] * SC_W, s[15 * 33] * SC_W);
            *(GAS u32x4*)(d.dst + (size_t)n * d.ldkb + 16 * c4) = o; }
    } else
#pragma unroll
    for (int j = 0; j < 4; ++j) { const int n = (lane >> 3) + 8 * j; const LAS float* s = scr + (8 * c) * 33 + n;
        { u32x4 o; o.x = pk2(s[0 * 33], s[1 * 33]); o.y = pk2(s[2 * 33], s[3 * 33]); o.z = pk2(s[4 * 33], s[5 * 33]); o.w = pk2(s[6 * 33], s[7 * 33]);
            *(GAS u32x4*)(d.dst + (size_t)n * d.ldkb + 16 * c) = o; } }
    LDS_WAIT(); asm volatile("" ::: "memory");
}

__global__ void __launch_bounds__(NWAVES * 64, 2) fwd(Args args) {
    extern __shared__ __attribute__((aligned(16))) unsigned char lds[];
    LAS unsigned char* L = (LAS unsigned char*)lds;
    volatile LAS unsigned* MISC = (volatile LAS unsigned*)(L + X_MISC);
    const int tid = threadIdx.x, lane = tid & 63, wave = __builtin_amdgcn_readfirstlane(tid >> 6);
    const int G = gridDim.x; const int bx = blockIdx.x; const int vcu = (G % 8 == 0) ? (bx % 8) * (G / 8) + bx / 8 : bx;
    unsigned char* ws = args.ws;
    gu32* ctl = (gu32*)(ws + WS_CTL);
#if EPDUP_MODE == 2
    if (tid == 0) pg8::epdup_base = ws + WS_WIN8; __syncthreads();
#endif
    const float* x = args.in[0]; float* out = args.out;
    bf16_t* Win_t = (bf16_t*)(ws + WS_WIN); bf16_t* Wab_t = (bf16_t*)(ws + WS_WAB); bf16_t* Wo_t = (bf16_t*)(ws + WS_WO);
    bf16_t* Wgu_t = (bf16_t*)(ws + WS_WGU); bf16_t* Wd_t = (bf16_t*)(ws + WS_WD);
    float* LF = (float*)(ws + WS_LF); float* CB = (float*)(ws + WS_CB);
    float* RSTDS = (float*)(ws + WS_RSTD);
    int* TOKL = (int*)(ws + WS_TOKL); int* TINFO = (int*)(ws + WS_TINFO); float* RGATE = (float*)(ws + WS_RGATE);
    bf16_t* HB = (bf16_t*)(ws + WS_H);
    bf16_t* QA = (bf16_t*)(ws + WS_QA); bf16_t* KA = (bf16_t*)(ws + WS_KA); bf16_t* VA = (bf16_t*)(ws + WS_VA);
    bf16_t* QBp = (bf16_t*)(ws + WS_QB); bf16_t* KBp = (bf16_t*)(ws + WS_KB); bf16_t* VBp = (bf16_t*)(ws + WS_VB);
    bf16_t* GATE = (bf16_t*)(ws + WS_GATE); bf16_t* OG = (bf16_t*)(ws + WS_OG); float* LSE = (float*)(ws + WS_LSE);
    bf16_t* OAB = (bf16_t*)(ws + WS_OAB); bf16_t* MRG = (bf16_t*)(ws + WS_MRG);
    bf16_t* MID = (bf16_t*)(ws + WS_MID); bf16_t* YB = (bf16_t*)(ws + WS_Y);

    for (int u = tid; u < 512 / 4; u += NWAVES * 64) ((LAS unsigned*)(L + X_MISC))[u] = 0u;
    __syncthreads();
    XcdBarrier bar; bar.bar = (unsigned*)(ctl + CW_BAR); bar.x = 0; bar.st = nullptr;
    if (N_LAUNCHES == 1) bar = xcd_barrier_post((unsigned*)(ctl + CW_BAR), MISC + 8);
#define GRID_BAR() do { if (N_LAUNCHES == 1) xcd_barrier(bar); } while (0)
    const int lo = args.ph_lo, hi_ph = args.ph_hi;
#ifndef PH_MASK
#define PH_MASK 0x3ff
#endif
#define IN(k) ((((PH_MASK) >> (k)) & 1) && lo <= (k) && (k) < hi_ph)
#define BOTH(k) (IN(k) && IN((k) + 1))
    const int gw = vcu * NWAVES + wave, NGW = G * NWAVES;

    constexpr int I_IN = 16 * 184, I_A = 4 * 32, I_B = 8 * 32, I_O = 16 * 32, I_GU = 16 * 64, I_D = 16 * 32;
    constexpr int NITEMS = I_IN + I_A + I_B + I_O + NEXP * (I_GU + I_D), NSMALL = I_IN + I_A + I_B + I_O; static_assert(NITEMS - NSMALL == 768 * 64, "conversion chunks");
#define TR_DECODE(D, IT) do { int r = (IT); \
            if (r < I_IN) { const int kb = r / 184, nb = r % 184, pn = nb >> 3, q = nb & 7, bj = q >> 2, wc = q & 3; \
                const int srcc = (pn < 15 ? 256 * pn : COL_G + 256 * (pn - 15)) + 64 * wc + 32 * bj; \
                const bool f8 = true; const int idx = pn; const int r0 = 256 * idx + 32 * (nb & 7);            \
                D.src = args.in[2] + (size_t)(64 * kb) * WIN_LD + srcc; D.ldn = WIN_LD; D.fp8 = f8; D.ldkb = f8 ? 1024 : 2048; \
                D.dst = ws + WS_WIN8ALL + (size_t)r0 * 1024 + 64 * kb; break; } r -= I_IN; \
            if (r < I_A) { D.src = args.in[10] + (size_t)(64 * (r / 32)) * 1024 + 32 * (r % 32); D.ldn = 1024; D.fp8 = false; D.ldkb = 1536; D.dst = ws + WS_WAB + (size_t)(32 * (r % 32)) * 1536 + 128 * (r / 32); break; } r -= I_A; \
            if (r < I_B) { D.src = args.in[11] + (size_t)(64 * (r / 32)) * 1024 + 32 * (r % 32); D.ldn = 1024; D.fp8 = false; D.ldkb = 1536; D.dst = ws + WS_WAB + (size_t)(32 * (r % 32)) * 1536 + 512 + 128 * (r / 32); break; } r -= I_B; \
            if (r < I_O) { D.src = args.in[12] + (size_t)(64 * (r / 32)) * 1024 + 32 * (r % 32); D.ldn = 1024; D.fp8 = false; D.ldkb = 2048; D.dst = ws + WS_WO + (size_t)(32 * (r % 32)) * 2048 + 128 * (r / 32); break; } r -= I_O; \
            if (r < NEXP * I_GU) { const int e = r / I_GU, rr = r % I_GU, kb = rr / 64, nb = rr % 64, pn = nb >> 3, q = nb & 7, bj = q >> 2; \
                D.src = args.in[16] + (size_t)e * 1024 * 2048 + (size_t)(64 * kb) * 2048 + bj * 1024 + 128 * pn + 32 * (q & 3); D.ldn = 2048; D.fp8 = true; D.ldkb = 1024; \
                D.dst = ws + WS_WGU + (size_t)e * 2048 * 1024 + (size_t)(32 * nb) * 1024 + 64 * kb; break; } r -= NEXP * I_GU; \
            { const int e = r / I_D, rr = r % I_D; D.src = args.in[18] + (size_t)e * 1024 * 1024 + (size_t)(64 * (rr / 32)) * 1024 + 32 * (rr % 32); D.ldn = 1024; D.fp8 = true; D.ldkb = 1024; \
              D.dst = ws + WS_WD + (size_t)e * 1024 * 1024 + (size_t)(32 * (rr % 32)) * 1024 + 64 * (rr / 32); } } while (0)
    if (IN(0)) {
        LAS float* scr = (LAS float*)(L + wave * 16384);
        if (gw < NSMALL) {
            TrItem cur; TR_DECODE(cur, gw); f32x4 tc[8]; tr_load(cur, tc, lane);
            for (int it = gw; it < NSMALL; it += NGW) {
                TrItem nxt = cur; f32x4 tn[8]; const bool has = it + NGW < NSMALL;
                if (has) { TR_DECODE(nxt, it + NGW); }
                tr_load(nxt, tn, lane);
                tr_store(cur, tc, scr, lane);
                cur = nxt;
#pragma unroll
                for (int i = 0; i < 8; ++i) tc[i] = tn[i];
            }
        }
        __syncthreads();
        LAS float* wf = (LAS float*)L;
        { float wv_[16];
#pragma unroll
          for (int q = 0; q < 16; ++q) { const int i = tid + NWAVES * 64 * q, k = i >> 3, j = i & 7; wv_[q] = args.in[2][(size_t)k * WIN_LD + COL_F + j]; }
#pragma unroll
          for (int q = 0; q < 16; ++q) { const int i = tid + NWAVES * 64 * q, k = i >> 3, j = i & 7; wf[j * 1024 + k] = wv_[q]; } }
        __syncthreads();
        const float* g1 = args.in[1]; const float* bfg = args.in[3];
        f32x4 gv[4];
#pragma unroll
        for (int j = 0; j < 4; ++j) gv[j] = *((const f32x4*)g1 + 64 * j + lane);
        for (int m0 = gw; m0 < NTOK; m0 += 2 * NGW) {
            const int m1 = (m0 + NGW < NTOK) ? m0 + NGW : m0;
            f32x4 v[2][4]; float ssq[2];
#pragma unroll
            for (int a = 0; a < 2; ++a) { const GAS f32x4* xr = (const GAS f32x4*)(x + (size_t)(a ? m1 : m0) * DM) + lane;
#pragma unroll
                for (int j = 0; j < 4; ++j) v[a][j] = __builtin_nontemporal_load(&xr[64 * j]); }
#pragma unroll
            for (int a = 0; a < 2; ++a) { float s = 0.f;
#pragma unroll
                for (int j = 0; j < 4; ++j) s += (v[a][j].x * v[a][j].x + v[a][j].y * v[a][j].y) + (v[a][j].z * v[a][j].z + v[a][j].w * v[a][j].w);
                ssq[a] = s; }
#pragma unroll
            for (int a = 0; a < 2; ++a) {
                const int m = a ? m1 : m0;
                const float rstd = __builtin_amdgcn_rsqf(wave_sum(ssq[a]) * (1.f / DM) + RMS_EPS);
                LAS unsigned* hst = (LAS unsigned*)(L + 65536 + wave * 2048 + a * 1024);
#pragma unroll
                for (int j = 0; j < 4; ++j) { v[a][j] = v[a][j] * rstd * gv[j]; hst[64 * j + lane] = pk4_fp8s(v[a][j].x * SC_H2, v[a][j].y * SC_H2, v[a][j].z * SC_H2, v[a][j].w * SC_H2); }
                LDS_WAIT();
                *((GAS u32x4*)(ws + WS_H8 + (size_t)m * DM) + lane) = *((const LAS u32x4*)hst + lane);
                float fl[8];
#pragma unroll
                for (int e = 0; e < 8; ++e) { float acc_ = 0.f;
#pragma unroll
                    for (int j = 0; j < 4; ++j) { const f32x4 w = *((const LAS f32x4*)(wf + e * 1024) + 64 * j + lane); acc_ += (v[a][j].x * w.x + v[a][j].y * w.y) + (v[a][j].z * w.z + v[a][j].w * w.w); }
                    fl[e] = acc_; }
                const bool c5 = lane & 32, c4 = lane & 16, c3 = lane & 8;
                float r4[4], r2[2], r1;
#pragma unroll
                for (int e = 0; e < 4; ++e) { const float keep = c5 ? fl[4 + e] : fl[e], send = c5 ? fl[e] : fl[4 + e]; r4[e] = keep + __shfl_xor(send, 32); }
#pragma unroll
                for (int e = 0; e < 2; ++e) { const float keep = c4 ? r4[2 + e] : r4[e], send = c4 ? r4[e] : r4[2 + e]; r2[e] = keep + __shfl_xor(send, 16); }
                { const float keep = c3 ? r2[1] : r2[0], send = c3 ? r2[0] : r2[1]; r1 = keep + __shfl_xor(send, 8); }
                r1 += __shfl_xor(r1, 4); r1 += __shfl_xor(r1, 2); r1 += __shfl_xor(r1, 1);
                if ((lane & 7) == 0) { const int e = lane >> 3; const float z = r1 + bfg[e]; LF[(size_t)m * 8 + e] = fminf(z, 0.f) - log1pf(__expf(-fabsf(z))); }
            }
        }
        if (BOTH(0)) GRID_BAR();
    }

    if (IN(1)) {
        for (int bh = vcu; bh < 64; bh += G) {
            const int b = bh >> 3, h = bh & 7; const float* lf = LF + ((size_t)b * SEQ + 8 * tid) * 8 + h;
            LAS float* wt = (LAS float*)(L + X_WS);
            float v[8]; float sacc = 0.f;
#pragma unroll
            for (int j = 0; j < 8; ++j) v[j] = lf[j * 8];
#pragma unroll
            for (int j = 0; j < 8; ++j) { sacc += v[j]; v[j] = sacc; }
            float incl = sacc;
#pragma unroll
            for (int o = 1; o < 64; o <<= 1) { const float t = __shfl_up(incl, o); if (lane >= o) incl += t; }
            if (lane == 63) wt[wave] = incl;
            __syncthreads();
            float basev = 0.f;
#pragma unroll
            for (int w = 0; w < 8; ++w) basev += (w < wave) ? wt[w] : 0.f;
            const float excl = basev + incl - sacc;
            f32x4 o0, o1;
            o0.x = (excl + v[0]) * LOG2E; o0.y = (excl + v[1]) * LOG2E; o0.z = (excl + v[2]) * LOG2E; o0.w = (excl + v[3]) * LOG2E;
            o1.x = (excl + v[4]) * LOG2E; o1.y = (excl + v[5]) * LOG2E; o1.z = (excl + v[6]) * LOG2E; o1.w = (excl + v[7]) * LOG2E;
            f32x4* cb = (f32x4*)(CB + (size_t)bh * SEQ + 8 * tid); cb[0] = o0; cb[1] = o1;
            __syncthreads();
        }
        { LAS float* nwl = (LAS float*)(L + X_NW);
          if (tid < 256) { const int j = tid >> 6, c = tid & 63; const float v = (j == 0 ? args.in[5] : (j == 1 ? args.in[6] : (j == 2 ? args.in[7] : args.in[8])))[c]; nwl[tid] = ((j & 1) == 0) ? v * QSCALE : v; }
          __syncthreads(); }
        { pg8::StaticOrder S; S.init((const bf16_t*)(ws + WS_H8), (const bf16_t*)(ws + WS_WIN8ALL), NTOK, 23 * 256, DM / 2, G, bx);
          pg8::EpiInProj<0> E{ws, (const LAS float*)(L + X_NW), args.in[4]};
          pg8::gemm_phase<pg8::EpiInProj<0>, pg8::StaticOrder, E8_H2>(L, S, E); }
        if (BOTH(1)) GRID_BAR();
    }

    if (IN(2)) {
        LAS int* qs = (LAS int*)(L + X_Q);
        if (tid < 64) {
            float a = fabsf(args.in[7][tid]), bq = fabsf(args.in[8][tid]);
#pragma unroll
            for (int o = 1; o < 64; o <<= 1) { a = fmaxf(a, __shfl_xor(a, o)); bq = fmaxf(bq, __shfl_xor(bq, o)); }
            if (tid == 0) ((LAS float*)qs)[2] = 48.0f + 2.04f * 64.0f * a * bq * QSCALE;
        }
        int n_dswa = 0;
        for (;;) {
            __syncthreads();
            if (tid == 0) qs[0] = (int)__hip_atomic_fetch_add(ctl + CW_QHEAD, 1u, RLX_AGENT);
            __syncthreads();
            const int it = qs[0];
            const bool leaving = (it >= 1536);
            if (leaving && n_dswa) {
                VM_WAIT(); __syncthreads();
                if (tid == 0) { __builtin_amdgcn_fence(__ATOMIC_RELEASE, "agent"); VM_WAIT(); __hip_atomic_fetch_add(ctl + CW_DSWA_DONE, (unsigned)n_dswa, RLX_AGENT); }
                n_dswa = 0;
            }
            if (it >= 3584) break;
            const int jq = it - 1536;
            if (it >= 1536 && jq < 1536 && (jq & 1)) {
                const int cc = jq >> 1; LAS float* scr = (LAS float*)(L + wave * 16384);
                const int ib = NSMALL + cc * 64 + wave * 8;
                TrItem ti3[3]; f32x4 tb3[3][8];
                TR_DECODE(ti3[0], ib); tr_load(ti3[0], tb3[0], lane); TR_DECODE(ti3[1], ib + 1); tr_load(ti3[1], tb3[1], lane);
#pragma unroll
                for (int i = 0; i < 8; ++i) {
                    if (i + 2 < 8) { TR_DECODE(ti3[(i + 2) % 3], ib + i + 2); tr_load(ti3[(i + 2) % 3], tb3[(i + 2) % 3], lane); }
                    tr_store(ti3[i % 3], tb3[i % 3], scr, lane);
                }
            } else if (it >= 1536 && it < 3328) {
                const int fi = jq < 1536 ? (jq >> 1) : jq - 768;
                const int qb = 15 - (fi >> 6), j = fi & 63, h = 7 - (j >> 3), b = j & 7;
                att::fox_unit<32>(b, h, qb, (const att::bf16*)QBp, (const att::bf16*)KBp, (const att::bf16*)VBp, (att::bf16*)OAB, CB, ((const LAS float*)qs)[2], (char*)lds);
            } else if (it < 1536) {
                const int uidx = it, g = uidx >> 9, rem = uidx & 511, b = rem >> 6, hg = (rem >> 4) & 3, w = rem & 15;
                const int nqb = 16 >> (2 * g), rres = w / nqb, qb = w % nqb;
                att::dswa_unit(b, g, hg, rres, qb, (const att::bf16*)QA, (const att::bf16*)KA, (const att::bf16*)VA, (att::bf16*)(OG + (size_t)g * NTOK * OAW), LSE + (size_t)g * NTOK * 4, args.in[9],
                               (char*)lds, (LAS float*)(L + X_LUT), (LAS float*)(L + X_WS));
                ++n_dswa;
            } else {
                if (tid == 0) { unsigned sp = 0; while (__hip_atomic_load(ctl + CW_DSWA_DONE, RLX_AGENT) < 1536u) { __builtin_amdgcn_s_sleep(2); if (++sp > (1u << 22)) break; }
                    __builtin_amdgcn_fence(__ATOMIC_ACQUIRE, "agent"); VM_WAIT(); }
                __syncthreads();
                const int c = it - 3328;
                for (int i0 = c * 4096 + tid; i0 < (c + 1) * 4096; i0 += 1024) {
                    float l0[2], l1[2], l2[2]; u32x4 a[2], bq[2], cq[2];
#pragma unroll
                    for (int q = 0; q < 2; ++q) { const int i = i0 + 512 * q, t = i >> 5, c8 = i & 31, hg = c8 >> 3;
                        l0[q] = LSE[(size_t)t * 4 + hg]; l1[q] = LSE[(size_t)NTOK * 4 + (size_t)t * 4 + hg]; l2[q] = LSE[(size_t)NTOK * 8 + (size_t)t * 4 + hg];
                        a[q] = __builtin_nontemporal_load((const u32x4*)(OG + (size_t)t * OAW + c8 * 8)); bq[q] = __builtin_nontemporal_load((const u32x4*)(OG + (size_t)NTOK * OAW + (size_t)t * OAW + c8 * 8)); cq[q] = __builtin_nontemporal_load((const u32x4*)(OG + (size_t)2 * NTOK * OAW + (size_t)t * OAW + c8 * 8)); }
                    asm volatile("" ::: "memory");
#pragma unroll
                    for (int q = 0; q < 2; ++q) { const int i = i0 + 512 * q, t = i >> 5, c8 = i & 31;
                        const float mx = fmaxf(l0[q], fmaxf(l1[q], l2[q]));
                        float w0 = __builtin_amdgcn_exp2f(l0[q] - mx), w1 = __builtin_amdgcn_exp2f(l1[q] - mx), w2 = __builtin_amdgcn_exp2f(l2[q] - mx);
                        const float inv = __builtin_amdgcn_rcpf(w0 + w1 + w2); w0 *= inv; w1 *= inv; w2 *= inv;
                        u32x4 o;
                        o.x = pk2(w0 * bflo(a[q].x) + w1 * bflo(bq[q].x) + w2 * bflo(cq[q].x), w0 * bfhi(a[q].x) + w1 * bfhi(bq[q].x) + w2 * bfhi(cq[q].x));
                        o.y = pk2(w0 * bflo(a[q].y) + w1 * bflo(bq[q].y) + w2 * bflo(cq[q].y), w0 * bfhi(a[q].y) + w1 * bfhi(bq[q].y) + w2 * bfhi(cq[q].y));
                        o.z = pk2(w0 * bflo(a[q].z) + w1 * bflo(bq[q].z) + w2 * bflo(cq[q].z), w0 * bfhi(a[q].z) + w1 * bfhi(bq[q].z) + w2 * bfhi(cq[q].z));
                        o.w = pk2(w0 * bflo(a[q].w) + w1 * bflo(bq[q].w) + w2 * bflo(cq[q].w), w0 * bfhi(a[q].w) + w1 * bfhi(bq[q].w) + w2 * bfhi(cq[q].w));
                        *(u32x4*)(OAB + (size_t)t * OABP + c8 * 8) = o; }
                }
            }
        }
        if (BOTH(2)) GRID_BAR();
    }

    if (IN(4)) {
        pg8::StaticOrder S; S.init(OAB, Wab_t, NTOK, DM, 768, G, bx); pg8::EpiMerge E{(const unsigned char*)GATE, MRG};
        pg8::gemm_phase<pg8::EpiMerge, pg8::StaticOrder>(L, S, E);
        if (BOTH(4)) GRID_BAR();
    }

    if (IN(5)) {
        pg8::StaticOrder S; S.init(MRG, Wo_t, NTOK, DM, DM, G, bx); pg8::EpiAtt E{x, (bf16_t*)(ws + WS_ATT)};
        pg8::gemm_phase<pg8::EpiAtt, pg8::StaticOrder>(L, S, E);
        if (BOTH(5)) GRID_BAR();
    }

    if (IN(6)) {
        const float* g2 = args.in[13]; const float* wr = args.in[14]; const float* br = args.in[15];
        for (int idx0 = tid; idx0 < 32 * 128; idx0 += 4 * NWAVES * 64) {
          float w4[4][8];
#pragma unroll
          for (int q = 0; q < 4; ++q) { const int idx = idx0 + q * NWAVES * 64, e = idx & 31, c = idx >> 5;
#pragma unroll
            for (int i = 0; i < 8; ++i) w4[q][i] = wr[(size_t)(8 * c + i) * 32 + e] * g2[8 * c + i]; }
#pragma unroll
          for (int q = 0; q < 4; ++q) { const int idx = idx0 + q * NWAVES * 64, e = idx & 31, c = idx >> 5;
            float (&w)[8] = w4[q];
            u32x4 hi4, lo4; unsigned hh[8];
#pragma unroll
            for (int i = 0; i < 8; ++i) hh[i] = f2bf(w[i]);
            hi4.x = hh[0] | (hh[1] << 16); hi4.y = hh[2] | (hh[3] << 16); hi4.z = hh[4] | (hh[5] << 16); hi4.w = hh[6] | (hh[7] << 16);
            lo4.x = pk2(w[0] - bf2f((unsigned short)hh[0]), w[1] - bf2f((unsigned short)hh[1])); lo4.y = pk2(w[2] - bf2f((unsigned short)hh[2]), w[3] - bf2f((unsigned short)hh[3]));
            lo4.z = pk2(w[4] - bf2f((unsigned short)hh[4]), w[5] - bf2f((unsigned short)hh[5])); lo4.w = pk2(w[6] - bf2f((unsigned short)hh[6]), w[7] - bf2f((unsigned short)hh[7]));
            const int off = e * 2048 + ((c ^ (e & 15)) << 4);
            *(LAS u32x4*)(L + off) = hi4; *(LAS u32x4*)(L + 65536 + off) = lo4; } }
        { const float ga_ = g2[tid], gb_ = g2[tid + NWAVES * 64]; ((LAS float*)(L + X_G2))[tid] = ga_; ((LAS float*)(L + X_G2))[tid + NWAVES * 64] = gb_; }
        LAS int* lcnt = (LAS int*)(L + X_RCNT); LAS int* lbase = lcnt + 32;
        LAS int* rsel = (LAS int*)(L + X_RSEL); LAS float* rgt = (LAS float*)(L + X_RSEL + 2048); LAS float* rstl = (LAS float*)(L + X_RSTD);
        const int fr = lane & 15, fq = lane >> 4;
        float brl[2][4];
#pragma unroll
        for (int n = 0; n < 2; ++n)
#pragma unroll
            for (int r = 0; r < 4; ++r) brl[n][r] = br[16 * n + 4 * fq + r];
        for (int ch = vcu; ch < NTOK / 128; ch += G) {
            if (tid < 32) lcnt[tid] = 0;
            __syncthreads();
            const int tok = ch * 128 + wave * 16 + fr;
            const GAS u32x4* ar = (const GAS u32x4*)((const bf16_t*)(ws + WS_ATT) + (size_t)tok * DM + 8 * fq);
            GAS unsigned char* h16 = (GAS unsigned char*)HB + (size_t)tok * DM + 8 * (fq & 2) + 32 * (fq & 1);
            u32x2 w8p = {0u, 0u};
            f32x4 acc[2]; acc[0] = (f32x4){0.f, 0.f, 0.f, 0.f}; acc[1] = acc[0];
            float ssq = 0.f;
            constexpr int P6R = 12;
            u32x4 as8[P6R];
            const LAS f32x4* g2l = (const LAS f32x4*)(L + X_G2) + 2 * fq;
#define P6_LOAD(slot, stv) do { as8[slot] = __builtin_nontemporal_load(&ar[4 * (stv)]); } while (0)
#pragma unroll
            for (int st = 0; st < P6R; ++st) P6_LOAD(st, st);
#pragma unroll
            for (int st = 0; st < 32; ++st) { const int slot = st % P6R;
                    const u32x4 aq = as8[slot]; const f32x4 ga = g2l[8 * st], gb = g2l[8 * st + 1];
                    const f32x4 x0 = {bflo(aq.x), bfhi(aq.x), bflo(aq.y), bfhi(aq.y)}, x1v = {bflo(aq.z), bfhi(aq.z), bflo(aq.w), bfhi(aq.w)};
                    if (st + P6R < 32) P6_LOAD(slot, st + P6R);
                    ssq += (x0.x * x0.x + x0.y * x0.y) + (x0.z * x0.z + x0.w * x0.w) + (x1v.x * x1v.x + x1v.y * x1v.y) + (x1v.z * x1v.z + x1v.w * x1v.w);
                    { u32x2 w8; w8.x = pk4_fp8s(x0.x * ga.x * SC_H2, x0.y * ga.y * SC_H2, x0.z * ga.z * SC_H2, x0.w * ga.w * SC_H2); w8.y = pk4_fp8s(x1v.x * gb.x * SC_H2, x1v.y * gb.y * SC_H2, x1v.z * gb.z * SC_H2, x1v.w * gb.w * SC_H2);
                      if (st & 1) {
                          const auto sa = __builtin_amdgcn_permlane16_swap(w8p.x, w8.x, false, false), sb = __builtin_amdgcn_permlane16_swap(w8p.y, w8.y, false, false);
                          u32x4 o16; o16.x = sa[0]; o16.y = sb[0]; o16.z = sa[1]; o16.w = sb[1];
                          *(GAS u32x4*)((GAS unsigned char*)h16 + 32 * (st - 1)) = o16; }
                      w8p = w8; }
                    const bf16x8 ah = __builtin_bit_cast(bf16x8, aq);
#pragma unroll
                    for (int n = 0; n < 2; ++n) { const int off = (16 * n + fr) * 2048 + (((4 * st + fq) ^ fr) << 4);
                        const bf16x8 wh = *(const LAS bf16x8*)(L + off), wl = *(const LAS bf16x8*)(L + 65536 + off);
                        acc[n] = __builtin_amdgcn_mfma_f32_16x16x32_bf16(wh, ah, acc[n], 0, 0, 0);
                        acc[n] = __builtin_amdgcn_mfma_f32_16x16x32_bf16(wl, ah, acc[n], 0, 0, 0); }
            }
#undef P6_LOAD
            ssq += __shfl_xor(ssq, 16); ssq += __shfl_xor(ssq, 32);
            const float rstd = __builtin_amdgcn_rsqf(ssq * (1.f / DM) + RMS_EPS);
            float lg[2][4];
#pragma unroll
            for (int n = 0; n < 2; ++n)
#pragma unroll
                for (int r = 0; r < 4; ++r) lg[n][r] = acc[n][r] * rstd + brl[n][r];
            float tv[4]; int ti[4];
#pragma unroll
            for (int k = 0; k < 4; ++k) { float bv = -INFINITY; int bi = 64;
#pragma unroll
                for (int n = 0; n < 2; ++n)
#pragma unroll
                    for (int r = 0; r < 4; ++r) { const int id = 16 * n + 4 * fq + r; if (lg[n][r] > bv) { bv = lg[n][r]; bi = id; } }
#pragma unroll
                for (int o = 16; o <= 32; o <<= 1) { const float ov = __shfl_xor(bv, o); const int oi = __shfl_xor(bi, o); if (ov > bv || (ov == bv && oi < bi)) { bv = ov; bi = oi; } }
                tv[k] = bv; ti[k] = bi;
#pragma unroll
                for (int n = 0; n < 2; ++n)
#pragma unroll
                    for (int r = 0; r < 4; ++r) if (16 * n + 4 * fq + r == bi) lg[n][r] = -INFINITY; }
            const float e1 = __expf(tv[1] - tv[0]), e2 = __expf(tv[2] - tv[0]), e3 = __expf(tv[3] - tv[0]); const float inv = 1.0f / (1.0f + e1 + e2 + e3);
            { const int e = fq == 0 ? ti[0] : (fq == 1 ? ti[1] : (fq == 2 ? ti[2] : ti[3])); const float gt = (fq == 0 ? 1.0f : (fq == 1 ? e1 : (fq == 2 ? e2 : e3))) * inv;
              const int rank = __hip_atomic_fetch_add(lcnt + e, 1, __ATOMIC_RELAXED, __HIP_MEMORY_SCOPE_WORKGROUP); const int tl = wave * 16 + fr;
              rsel[tl * 4 + fq] = (e << 16) | rank; rgt[tl * 4 + fq] = gt; if (fq == 0) rstl[tl] = rstd; }
            __syncthreads();
            if (tid < 32) lbase[tid] = (int)__hip_atomic_fetch_add(ctl + CW_ECNT + 64 * tid, (unsigned)lcnt[tid], RLX_AGENT);
            __syncthreads();
            { const int sel = rsel[tid], e = sel >> 16, pos = lbase[e] + (sel & 0xffff), t = ch * 128 + (tid >> 2);
              TOKL[(size_t)e * ECAP + pos] = t; RGATE[(size_t)e * ECAP + pos] = rgt[tid]; RSTDS[(size_t)e * ECAP + pos] = rstl[tid >> 2]; TINFO[(size_t)t * 4 + (tid & 3)] = (e << 16) | pos; }
            __syncthreads();
        }
        if (BOTH(6)) GRID_BAR();
    }

    LAS int* tpre = (LAS int*)(L + X_TPRE); LAS int* ecnt = tpre + 64;
    if (IN(7) || IN(8) || IN(9)) {
        if (tid < 32) ecnt[tid] = (int)__hip_atomic_load(ctl + CW_ECNT + 64 * tid, RLX_AGENT);
        __syncthreads();
        if (tid == 0) { int run = 0; for (int e = 0; e < NEXP; ++e) { tpre[e] = run; run += (ecnt[e] + 255) >> 8; } tpre[NEXP] = run; }
        __syncthreads();
    }

    if (IN(7)) {
        pg8::ExpertOrder<true, 8> S; S.A = HB; S.Bt = Wgu_t; S.K = DM / 2; S.N = 2048; S.tokl = TOKL; S.tpre = tpre; S.ecnt = ecnt; S.nN = 8; S.G = G; S.c = bx;
        pg8::EpiSwiglu E{args.in[17], (unsigned char*)MID, RSTDS, ecnt};
        pg8::gemm_phase<pg8::EpiSwiglu, pg8::ExpertOrder<true, 8>, E8_H2>(L, S, E);
        if (BOTH(7)) GRID_BAR();
    }
    if (IN(8)) {
        pg8::ExpertOrder<false, 8> S; S.A = MID; S.Bt = Wd_t; S.K = DM / 2; S.N = 1024; S.tokl = TOKL; S.tpre = tpre; S.ecnt = ecnt; S.nN = 4; S.G = G; S.c = bx;
        pg8::EpiDown E{args.in[19], RGATE, (unsigned char*)YB, ecnt};
        pg8::gemm_phase<pg8::EpiDown, pg8::ExpertOrder<false, 8>, E8_MID>(L, S, E);
        if (BOTH(8)) GRID_BAR();
    }
    if (IN(9)) {
        for (int m0 = gw; m0 < NTOK; m0 += 2 * NGW) {
            const bool two = (m0 + NGW < NTOK); const int m1 = two ? m0 + NGW : m0;
            f32x4 v[2][4]; int info[2][4];
            u32x2 av[2][4];
#pragma unroll
            for (int a = 0; a < 2; ++a) { const int m = a ? m1 : m0; const GAS u32x2* ar = (const GAS u32x2*)((const bf16_t*)(ws + WS_ATT) + (size_t)m * DM) + lane;
                { const u32x4 ti = *(const u32x4*)(TINFO + (size_t)m * 4); info[a][0] = (int)ti.x; info[a][1] = (int)ti.y; info[a][2] = (int)ti.z; info[a][3] = (int)ti.w; }
#pragma unroll
                for (int j = 0; j < 4; ++j) av[a][j] = __builtin_nontemporal_load(&ar[64 * j]); }
#pragma unroll
            for (int a = 0; a < 2; ++a)
#pragma unroll
                for (int j = 0; j < 4; ++j) { v[a][j].x = bflo(av[a][j].x); v[a][j].y = bfhi(av[a][j].x); v[a][j].z = bflo(av[a][j].y); v[a][j].w = bfhi(av[a][j].y); }
#pragma unroll
            for (int a = 0; a < 2; ++a)
#pragma unroll
                for (int k = 0; k < 4; ++k) { const int e = info[a][k] >> 16, pos = info[a][k] & 0xffff; const size_t row = (size_t)tpre[e] * 256 + pos;
                    const GAS unsigned* yr = (const GAS unsigned*)((const unsigned char*)YB + row * 1024) + lane;
#pragma unroll
                    for (int j = 0; j < 4; ++j) { const unsigned y = __builtin_nontemporal_load(&yr[64 * j]); const f32x2 lo = __builtin_amdgcn_cvt_pk_f32_fp8((int)y, false), hi = __builtin_amdgcn_cvt_pk_f32_fp8((int)y, true);
                        v[a][j].x += lo.x * (1.0f / SC_Y); v[a][j].y += lo.y * (1.0f / SC_Y); v[a][j].z += hi.x * (1.0f / SC_Y); v[a][j].w += hi.y * (1.0f / SC_Y); } }
            { GAS f32x4* xr = (GAS f32x4*)(out + (size_t)m0 * DM) + lane;
#pragma unroll
              for (int j = 0; j < 4; ++j) __builtin_nontemporal_store(v[0][j], &xr[64 * j]); }
            if (two) { GAS f32x4* xr = (GAS f32x4*)(out + (size_t)m1 * DM) + lane;
#pragma unroll
              for (int j = 0; j < 4; ++j) __builtin_nontemporal_store(v[1][j], &xr[64 * j]); }
        }
    }
#undef IN
#undef BOTH
#undef GRID_BAR
}

extern "C" void kernel_launch(void* const* d_in, const int* in_sizes, int n_in, void* d_out, int out_size, void* d_ws, size_t ws_size, hipStream_t stream) {
    static int grid = 0;
    if (grid == 0) {
        if (n_in != 20 || in_sizes[0] != NTOK * DM || out_size != NTOK * DM || ws_size < WS_END) {
            fprintf(stderr, "kernel_launch: unexpected shapes (n_in %d, in0 %d, out %d, ws %zu); nothing launched\n", n_in, n_in > 0 ? in_sizes[0] : -1, out_size, ws_size); grid = -1; return; }
        int dev = 0, cus = 0, per_cu = 0;
        if (hipGetDevice(&dev) != hipSuccess || hipDeviceGetAttribute(&cus, hipDeviceAttributeMultiprocessorCount, dev) != hipSuccess) { grid = -1; return; }
        if (hipFuncSetAttribute((const void*)fwd, hipFuncAttributeMaxDynamicSharedMemorySize, LDS_BYTES) != hipSuccess) { fprintf(stderr, "kernel_launch: hipFuncSetAttribute failed\n"); grid = -1; return; }
        if (hipOccupancyMaxActiveBlocksPerMultiprocessor(&per_cu, (const void*)fwd, NWAVES * 64, LDS_BYTES) != hipSuccess || per_cu < 1)
            fprintf(stderr, "kernel_launch: occupancy query reports %d workgroups per CU\n", per_cu);
        (void)hipGetLastError();
        grid = cus;
    }
    if (grid < 0) return;
    if (hipMemsetAsync((char*)d_ws + WS_CTL, 0, CTL_ZERO_BYTES, stream) != hipSuccess) return;
    Args a{};
    for (int i = 0; i < 20; ++i) a.in[i] = (const float*)d_in[i];
    a.out = (float*)d_out; a.ws = (unsigned char*)d_ws;
    if (N_LAUNCHES == 1) { a.ph_lo = 0; a.ph_hi = N_PHASES; a.li = 0; hipLaunchKernelGGL(fwd, dim3(grid), dim3(NWAVES * 64), LDS_BYTES, stream, a); }
    else for (int li = 0; li < N_PHASES; ++li) { a.ph_lo = li; a.ph_hi = li + 1; a.li = li; hipLaunchKernelGGL(fwd, dim3(grid), dim3(NWAVES * 64), LDS_BYTES, stream, a); }
}
```

```cpp
#include <hip/hip_runtime.h>
#include <hip/hip_bf16.h>
#include <cstdio>
#include <cstdint>
#include <cmath>

#ifndef MK_N_LAUNCHES
#define MK_N_LAUNCHES 1
#endif

#define GAS __attribute__((address_space(1)))
#define LAS __attribute__((address_space(3)))
typedef unsigned short bf16_t;
typedef short bf16x8 __attribute__((ext_vector_type(8)));
typedef short s16x4 __attribute__((ext_vector_type(4)));
typedef float f32x2 __attribute__((ext_vector_type(2)));
typedef float f32x4 __attribute__((ext_vector_type(4)));
typedef float f32x16 __attribute__((ext_vector_type(16)));
typedef unsigned u32x2 __attribute__((ext_vector_type(2)));
typedef unsigned u32x4 __attribute__((ext_vector_type(4)));
typedef GAS unsigned gu32;
#define RLX_AGENT __ATOMIC_RELAXED, __HIP_MEMORY_SCOPE_AGENT
#define LDS_WAIT() asm volatile("s_waitcnt lgkmcnt(0)" ::: "memory")
#define VM_WAIT() asm volatile("s_waitcnt vmcnt(0)" ::: "memory")

constexpr int NB = 8, SEQ = 4096, DM = 1024, NTOK = NB * SEQ;
constexpr int AW = 768, BW = 512, OAW = 256;
constexpr int NPROJ = 5888, WIN_LD = 5896;
constexpr int COL_F = 3840, COL_G = 3848;
constexpr int NEXP = 32, TOPK = 4, ECAP = NTOK;
constexpr float LOG2E = 1.4426950408889634f;
constexpr float QSCALE = 0.125f * LOG2E;
constexpr float RMS_EPS = 1e-6f;

constexpr size_t MiB = 1u << 20;
constexpr size_t WS_CTL = 0, CTL_ZERO_BYTES = 32 * 1024;
constexpr size_t WS_WIN = 2 * MiB;
constexpr size_t WS_WAB = 14 * MiB;
constexpr size_t WS_WO = 16 * MiB;
constexpr size_t WS_WGU = 18 * MiB;
constexpr size_t WS_WD = 146 * MiB;
constexpr size_t WS_LF = 210 * MiB;
constexpr size_t WS_CB = 211 * MiB;
constexpr size_t WS_TOKL = 212 * MiB;
constexpr size_t WS_TINFO = 216 * MiB;
constexpr size_t WS_RGATE = 217 * MiB;
constexpr size_t WS_H = 222 * MiB;
constexpr size_t WS_QA = 286 * MiB, WS_KA = 334 * MiB, WS_VA = 382 * MiB;
constexpr size_t WS_QB = 430 * MiB, WS_KB = 462 * MiB, WS_VB = 494 * MiB;
constexpr size_t WS_GATE = 526 * MiB;
constexpr size_t WS_OG = 654 * MiB;
constexpr size_t WS_LSE = 702 * MiB;
constexpr size_t WS_OAB = 704 * MiB;
constexpr int OABP = 768;
constexpr size_t WS_MRG = 752 * MiB;
constexpr size_t WS_MID = 286 * MiB;
constexpr size_t WS_Y = 558 * MiB;
constexpr size_t WS_H8 = 832 * MiB;
constexpr size_t WS_WIN8 = 864 * MiB;
constexpr size_t WS_RSTD = 868 * MiB;
constexpr size_t WS_ATT = 872 * MiB;
constexpr size_t WS_WIN8ALL = 936 * MiB;
constexpr size_t WS_END = 944 * MiB;
constexpr int PADROWS = NTOK * TOPK + NEXP * 256;
static_assert(WS_MID + (size_t)PADROWS * 1024 * 2 <= WS_Y && WS_Y + (size_t)PADROWS * 1024 * 2 <= WS_END, "ws map");
constexpr int CW_ECNT = 1024;
constexpr int CW_QHEAD = 3072, CW_DSWA_DONE = 3136;
constexpr int CW_BAR = 4096;

constexpr int RING_BYTES = 131072;
constexpr int X_OFF = RING_BYTES;
constexpr int X_MISC = X_OFF;
constexpr int X_TPRE = X_OFF + 512;
constexpr int X_WS = X_OFF + 1024;
constexpr int X_LUT = X_OFF + 3072;
constexpr int X_RCNT = X_OFF + 4096;
constexpr int X_RSEL = X_OFF + 5120;
constexpr int X_Q = X_OFF + 10240;
constexpr int X_RSTD = X_OFF + 10752;
constexpr int X_G2 = X_OFF + 12288;
constexpr int X_ETAB = X_OFF + 12288;
constexpr int X_UL = X_OFF + 11264;
constexpr int X_NW = X_OFF + 9216;
constexpr int LDS_BYTES = RING_BYTES + 16384;

__device__ __forceinline__ unsigned f2bf(float f) { unsigned u = __builtin_bit_cast(unsigned, f); return (u + 0x7fffu + ((u >> 16) & 1u)) >> 16; }
__device__ __forceinline__ unsigned pk2(float lo, float hi) { return f2bf(lo) | (f2bf(hi) << 16); }
__device__ __forceinline__ float bf2f(unsigned short b) { return __builtin_bit_cast(float, (unsigned)b << 16); }
__device__ __forceinline__ float bflo(unsigned w) { return __builtin_bit_cast(float, w << 16); }
__device__ __forceinline__ float bfhi(unsigned w) { return __builtin_bit_cast(float, w & 0xffff0000u); }
__device__ __forceinline__ float wave_sum(float v) {
#pragma unroll
    for (int o = 1; o < 64; o <<= 1) v += __shfl_xor(v, o);
    return v;
}
__device__ __forceinline__ unsigned pk4_u8(float a, float b, float c, float d) { unsigned w; asm("v_cvt_pk_u8_f32 %0, %1, 0, 0\n\tv_cvt_pk_u8_f32 %0, %2, 1, %0\n\tv_cvt_pk_u8_f32 %0, %3, 2, %0\n\tv_cvt_pk_u8_f32 %0, %4, 3, %0" : "=&v"(w) : "v"(a), "v"(b), "v"(c), "v"(d)); return w; }
__device__ __forceinline__ unsigned pk4_fp8(float a, float b, float c, float d) { int w = 0; w = __builtin_amdgcn_cvt_pk_fp8_f32(a, b, w, false); w = __builtin_amdgcn_cvt_pk_fp8_f32(c, d, w, true); return (unsigned)w; }
__device__ __forceinline__ unsigned pk4_fp8s(float a, float b, float c, float d) { return pk4_fp8(__builtin_amdgcn_fmed3f(a, -448.f, 448.f), __builtin_amdgcn_fmed3f(b, -448.f, 448.f), __builtin_amdgcn_fmed3f(c, -448.f, 448.f), __builtin_amdgcn_fmed3f(d, -448.f, 448.f)); }
constexpr float SC_H2 = 8.0f, SC_MID = 4.0f, SC_W = 256.0f, SC_Y = 16.0f;
constexpr int E8_H2 = 127 - 3, E8_MID = 127 - 2, E8_W = 127 - 8;
__device__ __forceinline__ float sigmoidf_fast(float x) { return __builtin_amdgcn_rcpf(1.0f + __builtin_amdgcn_exp2f(-x * LOG2E)); }

#define XB_TMO      128
#define XB_XCNT(j)  (256  + 64 * (j))
#define XB_XSUB(j)  (1280 + 64 * (j))
#define XB_XGEN(j)  (2304 + 64 * (j))
#define XB_TOP      3328
#define XB_TOPGEN   3392
#define XCD_BAR_WORDS 3456
#define XB_SPIN_CAP (1u << 20)
__device__ __forceinline__ unsigned xb_ld(unsigned* p)              { return __hip_atomic_load(p, __ATOMIC_RELAXED, __HIP_MEMORY_SCOPE_AGENT); }
__device__ __forceinline__ unsigned xb_add(unsigned* p, unsigned v) { return __hip_atomic_fetch_add(p, v, __ATOMIC_RELAXED, __HIP_MEMORY_SCOPE_AGENT); }
__device__ __forceinline__ unsigned xb_xcc_id() { return (unsigned)__builtin_amdgcn_s_getreg((3 << 11) | 20) & 0xFu; }
#define XB_SPIN(cond, bar) do { unsigned _sp = 0; while (cond) { __builtin_amdgcn_s_sleep(1); \
    if ((++_sp & 255u) == 0u) { if (xb_ld(&(bar)[XB_TMO])) break; if (_sp > XB_SPIN_CAP) { atomicAdd(&(bar)[XB_TMO], 1u); break; } } } } while (0)
struct XcdBarrier { unsigned* bar; unsigned x; volatile LAS unsigned* st; };
__device__ __forceinline__ XcdBarrier xcd_barrier_post(unsigned* bar, volatile LAS unsigned* st) {
    XcdBarrier b; b.bar = bar; b.x = xb_xcc_id(); b.st = st;
    if (threadIdx.x == 0) (void)xb_add(&bar[XB_XCNT(b.x)], 1u);
    return b;
}
__device__ __forceinline__ void xcd_barrier_complete(unsigned* bar, unsigned x, unsigned& nloc, unsigned& nx) {
    const unsigned G = gridDim.x * gridDim.y * gridDim.z;
    unsigned sum, cnt, mine, sp = 0u;
    for (;;) {
        sum = 0u; cnt = 0u; mine = 0u;
#pragma unroll
        for (unsigned j = 0; j < 16; ++j) { const unsigned c = xb_ld(&bar[XB_XCNT(j)]); sum += c; cnt += (c > 0u) ? 1u : 0u; mine = (j == x) ? c : mine; }
        if (sum == G) break;
        __builtin_amdgcn_s_sleep(1);
        if ((++sp & 255u) == 0u) { if (xb_ld(&bar[XB_TMO])) break; if (sp > XB_SPIN_CAP) { atomicAdd(&bar[XB_TMO], 1u); break; } }
    }
    nloc = mine > 0u ? mine : 1u; nx = cnt > 0u ? cnt : 1u;
}
__device__ __forceinline__ void xcd_barrier(const XcdBarrier& b) {
    asm volatile("s_waitcnt vmcnt(0)" ::: "memory");
    __syncthreads();
    if (threadIdx.x == 0) {
        unsigned* bar = b.bar;
        __builtin_amdgcn_s_waitcnt(0);
        unsigned nloc = b.st[0], nx = b.st[1];
        if (nloc == 0u) { xcd_barrier_complete(bar, b.x, nloc, nx); b.st[0] = nloc; b.st[1] = nx; }
        const unsigned old = xb_add(&bar[XB_XSUB(b.x)], 1u);
        const unsigned gen = old / nloc;
        if (old + 1u == (gen + 1u) * nloc) {
            __builtin_amdgcn_fence(__ATOMIC_RELEASE, "agent");
            asm volatile("s_waitcnt vmcnt(0)" ::: "memory");
            const unsigned og = xb_add(&bar[XB_TOP], 1u);
            const unsigned tg = og / nx;
            if (og + 1u == (tg + 1u) * nx) xb_add(&bar[XB_TOPGEN], 1u);
            else XB_SPIN(xb_ld(&bar[XB_TOPGEN]) == tg, bar);
            __builtin_amdgcn_fence(__ATOMIC_ACQUIRE, "agent");
            xb_add(&bar[XB_XGEN(b.x)], 1u);
            asm volatile("s_waitcnt vmcnt(0)" ::: "memory");
        } else {
            XB_SPIN(xb_ld(&bar[XB_XGEN(b.x)]) == gen, bar);
            __builtin_amdgcn_fence(__ATOMIC_ACQUIRE, "agent");
            asm volatile("s_waitcnt vmcnt(0)" ::: "memory");
        }
    }
    __syncthreads();
}

namespace pg8 {
constexpr int BM = 256, BK = 64, HALF = 128, HTB = HALF * BK * 2, STAGE_BYTES = 8 * HTB, NXCD = 8, WGM = 8;
__host__ __device__ __forceinline__ int lds_byte(int r, int c) { const int st = (r >> 4) * 2 + (c >> 5), rr = r & 15, cc = c & 31, ob = rr * 64 + cc * 2; return st * 1024 + (ob ^ (((ob >> 9) & 1) << 5)); }
__host__ __device__ __forceinline__ void stage_rc(int b, int& R, int& C) { const int st = b / 1024, sb = b % 1024, swz = sb ^ (((sb >> 9) & 1) << 5); R = (st >> 1) * 16 + swz / 64; C = (st & 1) * 32 + (swz % 64) / 2; }
__host__ __device__ __forceinline__ void stage_rc_u(unsigned b, unsigned& R, unsigned& C) { const unsigned st = b >> 10, sb = b & 1023u, swz = sb ^ (((sb >> 9) & 1u) << 5); R = (st >> 1) * 16u + (swz >> 6); C = (st & 1u) * 32u + ((swz & 63u) >> 1); }
__host__ __device__ __forceinline__ int perm32b(int rho) { const int n = rho >> 4, i = rho & 15, fq = i >> 2; return 16 * (fq & 1) + 8 * (fq >> 1) + 4 * n + (i & 3); }
__host__ __device__ __forceinline__ int perm32(int rho) { const int n = rho >> 4, i = rho & 15; return 8 * (i >> 2) + 4 * n + (i & 3); }

struct Unit { int pm, pn, e, mt, cnt; };

struct StaticOrder {
    static constexpr bool GATHER = false;
    const bf16_t* A; const bf16_t* Bt; int K;
    int nM, nN, nwg, G, c;
    __device__ void init(const bf16_t* A_, const bf16_t* Bt_, int M, int N, int K_, int G_, int c_) { A = A_; Bt = Bt_; K = K_; nM = M / BM; nN = N / BM; nwg = nM * nN; G = G_; c = c_; }
    __device__ bool next(int i, Unit& u) const {
        const long L = (long)i * G + c; if (L >= nwg) return false;
        int wgid = (int)L; { const int q = nwg / NXCD, r = nwg % NXCD, xcd = wgid % NXCD, off = wgid / NXCD; wgid = (xcd < r ? xcd * (q + 1) : r * (q + 1) + (xcd - r) * q) + off; }
        const int nig = WGM * nN, gid = wgid / nig, fm = gid * WGM, gsz = (nM - fm) < WGM ? (nM - fm) : WGM;
        u.pm = fm + ((wgid % nig) % gsz); u.pn = (wgid % nig) / gsz; u.e = 0; u.mt = u.pm; u.cnt = 0; return true;
    }
    __device__ __forceinline__ const char* a_base(const Unit& u) const { return (const char*)A + (size_t)u.pm * BM * K * 2; }
    __device__ __forceinline__ const char* b_base(const Unit& u) const { return (const char*)Bt + (size_t)u.pn * BM * K * 2; }
    __device__ __forceinline__ void a_voff(const Unit&, const int (&R)[2], const int (&C)[2], unsigned (&v)[2][2]) const {
#pragma unroll
        for (int h = 0; h < 2; ++h)
#pragma unroll
            for (int i = 0; i < 2; ++i) v[h][i] = (unsigned)((R[i] + HALF * h) * K + C[i]) * 2u;
    }
};
template <bool GATHER_, int XM> struct ExpertOrder {
    static constexpr bool GATHER = GATHER_;
    const bf16_t* A; const bf16_t* Bt; int K, N; const int* tokl;
    const LAS int* tpre; const LAS int* ecnt; int nN, G, c;
    __device__ bool next(int i, Unit& u) const {
        const int total = tpre[NEXP];
        int mt_all, pn;
        if constexpr (XM == 0) {
            if ((G & 7) == 0) {
                const long Lq = (long)i * G + c; const int x = (int)(Lq & 7); const int r = (int)(Lq >> 3);
                const int lo = (int)(((long)x * total) >> 3), hi = (int)(((long)(x + 1) * total) >> 3), nx = hi - lo;
                if (r >= nx * nN) return false;
                const int GR = 32 / nN;
                const int nig = GR * nN, g8 = r / nig, w = r - g8 * nig, gsz = (nx - GR * g8) < GR ? (nx - GR * g8) : GR;
                mt_all = lo + GR * g8 + (w % gsz); pn = w / gsz; }
            else { const long Lq = (long)i * G + c; mt_all = (int)(Lq / nN); pn = (int)(Lq % nN); }
        } else
        if ((G & 7) == 0) { const long Lq = (long)i * G + c; const int x = (int)(Lq & 7); const long r = Lq >> 3; const int q = (nN * XM) >> 3;
            mt_all = XM * (int)(r / q) + (x % XM); pn = q * (x / XM) + (int)(r % q); }
        else { const long Lq = (long)i * G + c; mt_all = (int)(Lq / nN); pn = (int)(Lq % nN); }
        if (mt_all >= total) return false;
        u.pn = pn; u.pm = mt_all;
        int e = 0;
#pragma unroll
        for (int s = 16; s >= 1; s >>= 1) { if (tpre[e + s] <= mt_all) e += s; }
        u.e = e; u.mt = mt_all - tpre[e]; u.cnt = ecnt[e]; return true;
    }
    __device__ __forceinline__ const char* a_base(const Unit& u) const { return GATHER ? (const char*)A : (const char*)A + (size_t)u.pm * BM * K * 2; }
    __device__ __forceinline__ const char* b_base(const Unit& u) const { return (const char*)Bt + ((size_t)u.e * N + (size_t)u.pn * BM) * K * 2; }
    __device__ __forceinline__ void a_tok_load(int e, int mt, int cnt, const int (&R)[2], int (&tk)[2][2]) const {
#pragma unroll
        for (int h = 0; h < 2; ++h)
#pragma unroll
            for (int i = 0; i < 2; ++i) { const int pos = mt * BM + R[i] + HALF * h; tk[h][i] = tokl[(size_t)e * ECAP + (pos < cnt ? pos : 0)]; }
    }
    __device__ __forceinline__ void a_voff_tok(const Unit& u, const int (&R)[2], const int (&C)[2], const int (&tk)[2][2], unsigned (&v)[2][2]) const {
        const int cnt = u.cnt;
#pragma unroll
        for (int h = 0; h < 2; ++h)
#pragma unroll
            for (int i = 0; i < 2; ++i) { const int pos = u.mt * BM + R[i] + HALF * h; const int tok = (pos < cnt) ? tk[h][i] : 0; v[h][i] = (unsigned)(tok * K + C[i]) * 2u; }
    }
    __device__ __forceinline__ void a_voff(const Unit& u, const int (&R)[2], const int (&C)[2], unsigned (&v)[2][2]) const {
        if constexpr (GATHER) {
            const int cnt = u.cnt;
#pragma unroll
            for (int h = 0; h < 2; ++h)
#pragma unroll
                for (int i = 0; i < 2; ++i) { const int pos = u.mt * BM + R[i] + HALF * h; const int tk = tokl[(size_t)u.e * ECAP + (pos < cnt ? pos : 0)]; const int tok = (pos < cnt) ? tk : 0;
                    v[h][i] = (unsigned)(tok * K + C[i]) * 2u; }
        } else {
#pragma unroll
            for (int h = 0; h < 2; ++h)
#pragma unroll
                for (int i = 0; i < 2; ++i) v[h][i] = (unsigned)((R[i] + HALF * h) * K + C[i]) * 2u;
        }
    }
};

typedef __bf16 bf16x2v __attribute__((ext_vector_type(2)));
__device__ __forceinline__ unsigned cvt_pk_bf16(float lo, float hi) { f32x2 v = {lo, hi}; bf16x2v b = __builtin_convertvector(v, bf16x2v); return __builtin_bit_cast(unsigned, b); }

typedef int i32x4 __attribute__((ext_vector_type(4)));
typedef int i32x8 __attribute__((ext_vector_type(8)));
__host__ __device__ __forceinline__ i32x8 cat8(bf16x8 a, bf16x8 b) { const i32x4 x = __builtin_bit_cast(i32x4, a), y = __builtin_bit_cast(i32x4, b); return __builtin_shufflevector(x, y, 0, 1, 2, 3, 4, 5, 6, 7); }
template <class Epi, class Sched, int FP8SC = 0>
__device__ __forceinline__ void gemm_phase(LAS unsigned char* lds, const Sched& S, const Epi& E) {
    const int tid = threadIdx.x, wid = __builtin_amdgcn_readfirstlane(tid >> 6), lane = tid & 63, wr = wid >> 2, wc = wid & 3, fr = lane & 15, fq = lane >> 4;
    const int K = S.K, nt = K / BK;
    int Rp[2], Cp[2]; unsigned voffB[2];
#pragma unroll
    for (int i = 0; i < 2; ++i) { stage_rc(tid * 16 + i * 8192, Rp[i], Cp[i]); const int Rb = Epi::PERM == 2 ? ((Rp[i] & ~31) + perm32b(Rp[i] & 31)) : Epi::PERM ? ((Rp[i] & ~31) + perm32(Rp[i] & 31)) : Rp[i]; voffB[i] = (unsigned)(Rb * K + Cp[i]) * 2u; }
    const size_t kstep = (size_t)(BK * 2);
    const size_t hstep = (size_t)HALF * K * 2;
    const unsigned ldsw = (unsigned)wid * 1024u;
    int aoff = lds_byte(wr * 64 + fr, fq * 8), boff = lds_byte(wc * 32 + fr, fq * 8);
#define PG8_SA(b, h) (((b) * 2 + (h)) * HTB)
#define PG8_SB(b, h) ((4 + (b) * 2 + (h)) * HTB)
#define PG8_STAGE(bufoff, gbase, voff) do { _Pragma("unroll") for (int _i = 0; _i < 2; ++_i) \
        __builtin_amdgcn_global_load_lds((const unsigned*)((const char*)(gbase) + (voff)[_i]), (LAS unsigned*)(lds + (bufoff) + ldsw + _i * 8192), 16, 0, 0); } while (0)
#define PG8_LD8(p) cat8(*(const LAS bf16x8*)(p), *(const LAS bf16x8*)((p) + 1024))
#define PG8_LDA(dst, b, h) do { if constexpr (FP8SC != 0) { _Pragma("unroll") for (int m = 0; m < 4; ++m) dst##8[m] = PG8_LD8(lds + PG8_SA(b, h) + aoff + m * 2048); } \
        else { _Pragma("unroll") for (int m = 0; m < 4; ++m) _Pragma("unroll") for (int k = 0; k < 2; ++k) dst[m][k] = *(const LAS bf16x8*)(lds + PG8_SA(b, h) + aoff + m * 2048 + k * 1024); } } while (0)
#define PG8_LDB(dst, b, h) do { if constexpr (FP8SC != 0) { _Pragma("unroll") for (int n = 0; n < 2; ++n) dst##8[n] = PG8_LD8(lds + PG8_SB(b, h) + boff + n * 2048); } \
        else { _Pragma("unroll") for (int n = 0; n < 2; ++n) _Pragma("unroll") for (int k = 0; k < 2; ++k) dst[n][k] = *(const LAS bf16x8*)(lds + PG8_SB(b, h) + boff + n * 2048 + k * 1024); } } while (0)
#define PG8_MMA(ai, bj, At, Bt) do { __builtin_amdgcn_s_setprio(1); \
        if constexpr (FP8SC != 0) { _Pragma("unroll") for (int m = 0; m < 4; ++m) _Pragma("unroll") for (int n = 0; n < 2; ++n) \
            asm volatile("v_mfma_scale_f32_16x16x128_f8f6f4 %0, %1, %2, %0, %3, %4 op_sel_hi:[0,0,0]" : "+v"(acc[ai][bj][m][n]) : "v"(Bt##8[n]), "v"(At##8[m]), "v"(scw), "v"(sca)); } \
        else { _Pragma("unroll") for (int m = 0; m < 4; ++m) _Pragma("unroll") for (int n = 0; n < 2; ++n) _Pragma("unroll") for (int k = 0; k < 2; ++k) \
            acc[ai][bj][m][n] = __builtin_amdgcn_mfma_f32_16x16x32_bf16(Bt[n][k], At[m][k], acc[ai][bj][m][n], 0, 0, 0); } \
        __builtin_amdgcn_s_setprio(0); } while (0)
#define PG8_WAIT_V(n) asm volatile("s_waitcnt vmcnt(" #n ")" ::: "memory")
#define PG8_WAIT_VR(c) asm volatile("v_cmp_eq_u32_e32 vcc, 0, %0\n\ts_cbranch_vccnz 1f\n\ts_waitcnt vmcnt(%1)\n\ts_branch 2f\n1:\n\ts_waitcnt vmcnt(8)\n2:" :: "v"(c), "n"(8 + Epi::NST) : "memory", "vcc")
#define PG8_WAIT_L(n) asm volatile("s_waitcnt lgkmcnt(" #n ")" ::: "memory")
#define PG8_BAR __builtin_amdgcn_s_barrier()
#define PG8_SCHED __builtin_amdgcn_sched_barrier(0)
    LAS i32x4* ulist = (LAS i32x4*)(lds + X_UL);
    if (tid < 64) { Unit u_; const bool ok_ = S.next(tid, u_); ulist[tid] = ok_ ? (i32x4){u_.pm, u_.pn | (u_.e << 16), u_.cnt, u_.mt} : (i32x4){-1, 0, 0, 0}; }
    __syncthreads();
    auto getu = [&](int i, Unit& u) -> bool { const i32x4 q_ = ulist[i < 64 ? i : 63];        u.pm = __builtin_amdgcn_readfirstlane(q_.x); const int pe_ = __builtin_amdgcn_readfirstlane(q_.y); u.pn = pe_ & 0xffff; u.e = pe_ >> 16; u.cnt = __builtin_amdgcn_readfirstlane(q_.z); u.mt = __builtin_amdgcn_readfirstlane(q_.w); return u.pm >= 0; };
    Unit cur, nxt, nx2; int ui = 0;
    if (!getu(0, cur)) return;
    unsigned voffA[2][2], voffN[2][2];
    S.a_voff(cur, Rp, Cp, voffA);
#pragma unroll
    for (int h = 0; h < 2; ++h)
#pragma unroll
        for (int i = 0; i < 2; ++i) voffN[h][i] = voffA[h][i];
    f32x4 acc[2][2][4][2];
#pragma unroll
    for (int a = 0; a < 2; ++a)
#pragma unroll
        for (int b = 0; b < 2; ++b)
#pragma unroll
            for (int m = 0; m < 4; ++m)
#pragma unroll
                for (int n = 0; n < 2; ++n) acc[a][b][m][n] = (f32x4){0.f, 0.f, 0.f, 0.f};
    bf16x8 At[4][2], B0[2][2], B1[2][2]; i32x8 At8[4], B08[2], B18[2];
    int scw = E8_W * 0x01010101, sca = FP8SC * 0x01010101; asm volatile("" : "+v"(scw), "+v"(sca));
    const char* cA = S.a_base(cur); const char* cB = S.b_base(cur);
    PG8_STAGE(PG8_SB(0, 0), cB, voffB); PG8_STAGE(PG8_SB(0, 1), cB + hstep, voffB); PG8_STAGE(PG8_SA(0, 0), cA, voffA[0]); PG8_STAGE(PG8_SA(0, 1), cA, voffA[1]);
    if (wr == 1) PG8_BAR;
    PG8_WAIT_V(2); PG8_BAR;
    PG8_STAGE(PG8_SB(1, 0), cB + kstep, voffB); PG8_STAGE(PG8_SA(1, 0), cA + kstep, voffA[0]); PG8_STAGE(PG8_SB(1, 1), cB + hstep + kstep, voffB);
    PG8_WAIT_V(6); PG8_BAR;
    bool has_next = getu(1, nxt);
    int tkn[2][2] = {{0, 0}, {0, 0}};
    if constexpr (Sched::GATHER) { S.a_tok_load(has_next ? nxt.e : cur.e, has_next ? nxt.mt : cur.mt, has_next ? nxt.cnt : cur.cnt, Rp, tkn); }
    for (;;) {
        if constexpr (Epi::TAB) E.tab_dma(cur, (unsigned)__builtin_amdgcn_readfirstlane((int)(uintptr_t)(lds + X_ETAB) + (ui & 1) * 2048), wid, lane);
        const char* nA = has_next ? S.a_base(nxt) : cA; const char* nB = has_next ? S.b_base(nxt) : cB;
        bool has2 = false;
        if constexpr (Sched::GATHER) { if (has_next) S.a_voff_tok(nxt, Rp, Cp, tkn, voffN);
            has2 = has_next && getu(ui + 2, nx2);
            S.a_tok_load(has2 ? nx2.e : (has_next ? nxt.e : cur.e), has2 ? nx2.mt : (has_next ? nxt.mt : cur.mt), has2 ? nx2.cnt : (has_next ? nxt.cnt : cur.cnt), Rp, tkn); }
        else { has2 = has_next && getu(ui + 2, nx2); }
#ifndef KREP
#define KREP 1
#endif
        for (int rep = 0; rep < KREP; ++rep) { const bool fin = (rep == KREP - 1);
        for (int t = 0; t < nt; t += 2) {
            const bool last = (t == nt - 2);
            if constexpr (Epi::MIDT > 0) { if (fin && t == Epi::MIDT) { int et_ = threadIdx.x; asm volatile("" : "+v"(et_)); E.mid(acc, cur, wr, wc, et_ & 15, (et_ >> 4) & 3); } }
            const char* a1 = cA + (size_t)(t + 1) * kstep;
            const char* a2 = last ? (fin ? nA : cA) : cA + (size_t)(t + 2) * kstep; const char* b2 = last ? (fin ? nB : cB) : cB + (size_t)(t + 2) * kstep;
            const char* a3 = a2 + kstep; const char* b3 = b2 + kstep;
            unsigned v2[2][2];
#pragma unroll
            for (int h = 0; h < 2; ++h)
#pragma unroll
                for (int i = 0; i < 2; ++i) v2[h][i] = (Sched::GATHER && last && fin) ? voffN[h][i] : voffA[h][i];
            const int rlx = ((t == 0) && (ui > 0) && (rep == 0)) ? 1 : 0;
            PG8_LDB(B0, 0, 0); PG8_LDB(B1, 0, 1); PG8_SCHED; PG8_LDA(At, 0, 0); PG8_STAGE(PG8_SA(1, 1), a1, voffA[1]);
            PG8_WAIT_VR(rlx);
            PG8_WAIT_L(0); PG8_BAR; PG8_MMA(0, 0, At, B0); PG8_MMA(0, 1, At, B1); PG8_BAR; PG8_SCHED;
            PG8_LDA(At, 0, 1); PG8_STAGE(PG8_SB(0, 0), b2, voffB); PG8_STAGE(PG8_SB(0, 1), b2 + hstep, voffB); PG8_STAGE(PG8_SA(0, 0), a2, v2[0]);
            PG8_WAIT_VR(rlx);
            PG8_WAIT_L(0); PG8_BAR; PG8_MMA(1, 0, At, B0); PG8_MMA(1, 1, At, B1); PG8_BAR; PG8_SCHED;
            PG8_LDB(B0, 1, 0); PG8_LDB(B1, 1, 1); PG8_SCHED; PG8_LDA(At, 1, 0); PG8_STAGE(PG8_SA(0, 1), a2, v2[1]);
            PG8_WAIT_V(8); PG8_WAIT_L(0); PG8_BAR; PG8_MMA(0, 0, At, B0); PG8_MMA(0, 1, At, B1); PG8_BAR; PG8_SCHED;
            PG8_LDA(At, 1, 1); PG8_STAGE(PG8_SB(1, 0), b3, voffB); PG8_STAGE(PG8_SB(1, 1), b3 + hstep, voffB); PG8_STAGE(PG8_SA(1, 0), a3, v2[0]);
            PG8_WAIT_V(8); PG8_WAIT_L(0); PG8_BAR; PG8_MMA(1, 0, At, B0); PG8_MMA(1, 1, At, B1); PG8_BAR; PG8_SCHED;
        }
        if (!fin) {
#pragma unroll
        for (int a = 0; a < 2; ++a)
#pragma unroll
            for (int b = 0; b < 2; ++b)
#pragma unroll
                for (int m = 0; m < 4; ++m)
#pragma unroll
                    for (int n = 0; n < 2; ++n) acc[a][b][m][n] = (f32x4){0.f, 0.f, 0.f, 0.f};
        } }
        if (wr == 0) PG8_BAR;
        if constexpr (FP8SC != 0) asm volatile("s_nop 15\n\ts_nop 15" ::: "memory");
        { int et_ = threadIdx.x; asm volatile("" : "+v"(et_)); const int efr = et_ & 15, efq = (et_ >> 4) & 3;
          if constexpr (Epi::TAB) E(acc, cur, wr, wc, efr, efq, (const LAS float*)(lds + X_ETAB + (ui & 1) * 2048)); else E(acc, cur, wr, wc, efr, efq); }
        if (!has_next) break;
#pragma unroll
        for (int a = 0; a < 2; ++a)
#pragma unroll
            for (int b = 0; b < 2; ++b)
#pragma unroll
                for (int m = 0; m < 4; ++m)
#pragma unroll
                    for (int n = 0; n < 2; ++n) acc[a][b][m][n] = (f32x4){0.f, 0.f, 0.f, 0.f};
        cur = nxt; nxt = nx2; has_next = has2; cA = nA; cB = nB; ++ui;
#pragma unroll
        for (int h = 0; h < 2; ++h)
#pragma unroll
            for (int i = 0; i < 2; ++i) voffA[h][i] = voffN[h][i];
        if (wr == 1) PG8_BAR;
    }
    PG8_WAIT_V(0);
    PG8_BAR;
#undef PG8_SA
#undef PG8_SB
#undef PG8_STAGE
#undef PG8_LDA
#undef PG8_LD8
#undef PG8_LDB
#undef PG8_MMA
#undef PG8_WAIT_V
#undef PG8_WAIT_VR
#undef PG8_WAIT_L
#undef PG8_BAR
#undef PG8_SCHED
}

typedef const f32x4 (&AccRef)[2][2][4][2];
__device__ __forceinline__ void glds4w(const void* gsrc, unsigned lds_dst) { unsigned keep;
    asm volatile("s_mov_b32 %0, m0\n\ts_mov_b32 m0, %2\n\ts_nop 0\n\tglobal_load_lds_dword %1, off\n\ts_mov_b32 m0, %0" : "=&s"(keep) : "v"(gsrc), "s"(lds_dst) : "memory"); }
#ifndef EPDUP_MODE
#define EPDUP_MODE 0
#endif
#if EPDUP_MODE == 2
__device__ unsigned char* epdup_base;
#endif
template <class P> __device__ __forceinline__ void epst(P* p, u32x4 v) {
    *(u32x4*)p = v;
#if EPDUP_MODE == 1
    *(volatile u32x4*)p = v;
#elif EPDUP_MODE == 2
    *(volatile u32x4*)(epdup_base + (size_t)blockIdx.x * 16384 + (threadIdx.x >> 6) * 2048 + (threadIdx.x & 63) * 16) = v;
#endif
}
#define EPST(p, v) epst((p), (v))
__device__ __forceinline__ u32x4 pair_rows(u32x2 X, u32x2 Y) { const auto a = __builtin_amdgcn_permlane32_swap(X.x, Y.x, false, false), b = __builtin_amdgcn_permlane32_swap(X.y, Y.y, false, false);
    u32x4 o; o.x = a[0]; o.y = b[0]; o.z = a[1]; o.w = b[1]; return o; }
#define DEAL_SRC(ln) ((((ln) & 3) << 6) | (((ln) >> 2) << 2))
__device__ __forceinline__ u32x4 deal4(u32x4 v, int bpa) { u32x4 t; t.x = (unsigned)__builtin_amdgcn_ds_bpermute(bpa, (int)v.x); t.y = (unsigned)__builtin_amdgcn_ds_bpermute(bpa, (int)v.y);
    t.z = (unsigned)__builtin_amdgcn_ds_bpermute(bpa, (int)v.z); t.w = (unsigned)__builtin_amdgcn_ds_bpermute(bpa, (int)v.w); return t; }
__device__ __forceinline__ u32x2 deal2(u32x2 v, int bpa) { u32x2 t; t.x = (unsigned)__builtin_amdgcn_ds_bpermute(bpa, (int)v.x); t.y = (unsigned)__builtin_amdgcn_ds_bpermute(bpa, (int)v.y); return t; }
__device__ __forceinline__ u32x4 pack8(const f32x4& a, const f32x4& b) { u32x4 w; w.x = cvt_pk_bf16(a[0], a[1]); w.y = cvt_pk_bf16(a[2], a[3]); w.z = cvt_pk_bf16(b[0], b[1]); w.w = cvt_pk_bf16(b[2], b[3]); return w; }

template <int MODE> struct EpiInProj {
    static constexpr bool TAB = true;
    static constexpr bool PERM = true; static constexpr int MIDT = 0, NST = 16;
    unsigned char* ws; const LAS float* nwl; const float* bgate;
    __device__ __forceinline__ void tab_dma(const Unit& u, unsigned ldst, int wid, int lane) const {
        if (wid == 0 && u.pn >= 15) { const float* b = bgate + 256 * (u.pn - 15) + lane; glds4w(b, ldst); glds4w(b + 64, ldst + 256); glds4w(b + 128, ldst + 512); glds4w(b + 192, ldst + 768); }
    }
    __device__ __forceinline__ void operator()(AccRef acc, const Unit& u, int wr, int wc, int fr, int fq, const LAS float* tab) const {
        const int row0 = u.pm * BM + wr * 64 + fr;
        const int ln = fr + 16 * fq, bpa = DEAL_SRC(ln), rowd = u.pm * BM + wr * 64 + (ln >> 2), c4 = ln & 3;
        const int pn = u.pn;
        if (pn < 15) {
            int s, hb, pitch, nwi; size_t boff;
            if (pn < 9) { s = pn / 3; hb = 4 * (pn - 3 * s); pitch = AW; boff = WS_QA + (size_t)s * (WS_KA - WS_QA); nwi = s; }
            else { const int p2 = pn - 9; s = p2 >> 1; hb = 4 * (p2 & 1); pitch = BW; boff = WS_QB + (size_t)s * (WS_KB - WS_QB); nwi = 2 + s; }
            bf16_t* base = (bf16_t*)(ws + boff);
            const bool nrm = s < 2;
            const int colb = (hb + wc) * 64 + 8 * fq;
            f32x4 w[2][2];
#pragma unroll
            for (int bj = 0; bj < 2; ++bj)
#pragma unroll
                for (int n = 0; n < 2; ++n) { const f32x4 t = *(const LAS f32x4*)(nwl + (nrm ? nwi : 0) * 64 + 32 * bj + 8 * fq + 4 * n); w[bj][n] = nrm ? t : (f32x4){1.f, 1.f, 1.f, 1.f}; }
#pragma unroll
            for (int ai = 0; ai < 2; ++ai)
#pragma unroll
                for (int m = 0; m < 4; ++m) {
                    float ss = 0.f;
#pragma unroll
                    for (int bj = 0; bj < 2; ++bj)
#pragma unroll
                        for (int n = 0; n < 2; ++n) { const f32x4 x = acc[ai][bj][m][n]; ss += (x[0] * x[0] + x[1] * x[1]) + (x[2] * x[2] + x[3] * x[3]); }
                    ss += __shfl_xor(ss, 16); ss += __shfl_xor(ss, 32);
                    const float r = nrm ? __builtin_amdgcn_rsqf(ss * (1.0f / 64.0f) + RMS_EPS) : 1.0f;
                    bf16_t* rowp = base + (size_t)(rowd + ai * HALF + m * 16) * pitch + (hb + wc) * 64 + 8 * c4;
#pragma unroll
                    for (int bj = 0; bj < 2; ++bj) { const f32x4 v0 = acc[ai][bj][m][0] * (w[bj][0] * r), v1 = acc[ai][bj][m][1] * (w[bj][1] * r); EPST(rowp + 32 * bj, deal4(pack8(v0, v1), bpa)); }
                }
        } else {
            unsigned char* gate = ws + WS_GATE;
            const int colb = 256 * (pn - 15) + 64 * wc + 8 * fq;
            f32x4 bb[2][2];
#pragma unroll
            for (int bj = 0; bj < 2; ++bj)
#pragma unroll
                for (int n = 0; n < 2; ++n) bb[bj][n] = *(const LAS f32x4*)(tab + 64 * wc + 8 * fq + 32 * bj + 4 * n);
#pragma unroll
            for (int ai = 0; ai < 2; ++ai)
#pragma unroll
                for (int m = 0; m < 4; ++m) { unsigned char* rowp = gate + (size_t)(rowd + ai * HALF + m * 16) * 2048 + 256 * (pn - 15) + 64 * wc + 8 * c4;
#pragma unroll
                    for (int bj = 0; bj < 2; ++bj) { f32x4 v0 = (acc[ai][bj][m][0] + bb[bj][0]) * (-LOG2E), v1 = (acc[ai][bj][m][1] + bb[bj][1]) * (-LOG2E);
#pragma unroll
                        for (int e = 0; e < 4; ++e) { v0[e] = __builtin_amdgcn_exp2f(v0[e]); v1[e] = __builtin_amdgcn_exp2f(v1[e]); }
                        v0 = v0 + 1.0f; v1 = v1 + 1.0f;
#pragma unroll
                        for (int e = 0; e < 4; ++e) { v0[e] = __builtin_amdgcn_rcpf(v0[e]); v1[e] = __builtin_amdgcn_rcpf(v1[e]); }
                        v0 = v0 * 255.0f; v1 = v1 * 255.0f;
#pragma unroll
                        for (int e = 0; e < 4; ++e) { v0[e] = __builtin_rintf(v0[e]); v1[e] = __builtin_rintf(v1[e]); }
                        u32x2 o; o.x = pk4_u8(v0[0], v0[1], v0[2], v0[3]); o.y = pk4_u8(v1[0], v1[1], v1[2], v1[3]);
                        *(u32x2*)(rowp + 32 * bj) = deal2(o, bpa); } }
        }
    }
};
template <bool SECOND> struct EpiBranch {
    static constexpr bool TAB = false;
    static constexpr bool PERM = true; static constexpr int MIDT = 0, NST = 16;
    const bf16_t* gate; bf16_t* mrg;
    __device__ __forceinline__ void operator()(AccRef acc, const Unit& u, int wr, int wc, int fr, int fq) const {
        const int row0 = u.pm * BM + wr * 64 + fr, col0 = u.pn * BM + wc * 32 + 8 * fq;
#pragma unroll
        for (int ai = 0; ai < 2; ++ai) {
            u32x4 gv[4][2], tv[4][2];
#pragma unroll
            for (int m = 0; m < 4; ++m) { const size_t row = (size_t)(row0 + ai * HALF + m * 16);
#pragma unroll
                for (int bj = 0; bj < 2; ++bj) { const int col = col0 + bj * HALF; gv[m][bj] = *(const u32x4*)(gate + row * 2048 + (SECOND ? 1024 : 0) + col);
                    if (SECOND) tv[m][bj] = *(const u32x4*)(mrg + row * 1024 + col); } }
            asm volatile("" ::: "memory");
#pragma unroll
            for (int m = 0; m < 4; ++m) { const size_t row = (size_t)(row0 + ai * HALF + m * 16);
#pragma unroll
                for (int bj = 0; bj < 2; ++bj) { const int col = col0 + bj * HALF; const u32x4 g = gv[m][bj];
                    const f32x4 g0 = {bflo(g.x), bfhi(g.x), bflo(g.y), bfhi(g.y)}, g1 = {bflo(g.z), bfhi(g.z), bflo(g.w), bfhi(g.w)};
                    f32x4 v0 = acc[ai][bj][m][0] * g0, v1 = acc[ai][bj][m][1] * g1;
                    if (SECOND) { const u32x4 t = tv[m][bj]; const f32x4 t0 = {bflo(t.x), bfhi(t.x), bflo(t.y), bfhi(t.y)}, t1 = {bflo(t.z), bfhi(t.z), bflo(t.w), bfhi(t.w)}; v0 = v0 + t0; v1 = v1 + t1; }
                    *(u32x4*)(mrg + row * 1024 + col) = pack8(v0, v1); } }
            asm volatile("" ::: "memory");
        }
    }
};
struct EpiMerge {
    static constexpr bool TAB = false;
    static constexpr bool PERM = true; static constexpr int MIDT = 4, NST = 16;
    const unsigned char* gate; bf16_t* mrg;
    static __device__ __forceinline__ f32x4 ub4(unsigned w) { return (f32x4){(float)(w & 255u), (float)((w >> 8) & 255u), (float)((w >> 16) & 255u), (float)(w >> 24)}; }
    __device__ __forceinline__ void mid(f32x4 (&acc)[2][2][4][2], const Unit& u, int wr, int wc, int fr, int fq) const {
        const int row0 = u.pm * BM + wr * 64 + fr, col0 = u.pn * BM + wc * 32 + 8 * fq;
        u32x2 ga[2][4][2], gb[2][4][2];
#pragma unroll
        for (int ai = 0; ai < 2; ++ai)
#pragma unroll
            for (int m = 0; m < 4; ++m) { const size_t row = (size_t)(row0 + ai * HALF + m * 16);
#pragma unroll
                for (int bj = 0; bj < 2; ++bj) { const int col = col0 + bj * HALF; ga[ai][m][bj] = *(const u32x2*)(gate + row * 2048 + col); gb[ai][m][bj] = *(const u32x2*)(gate + row * 2048 + 1024 + col); } }
#pragma unroll
        for (int ai = 0; ai < 2; ++ai)
#pragma unroll
            for (int m = 0; m < 4; ++m)
#pragma unroll
                for (int bj = 0; bj < 2; ++bj) { const u32x2 a = ga[ai][m][bj], b = gb[ai][m][bj];
                    const f32x4 a0 = ub4(a.x), a1 = ub4(a.y); f32x4 b0 = ub4(b.x), b1 = ub4(b.y);
#pragma unroll
                    for (int e = 0; e < 4; ++e) { b0[e] = __builtin_amdgcn_rcpf(fmaxf(b0[e], 2.0116e-28f)); b1[e] = __builtin_amdgcn_rcpf(fmaxf(b1[e], 2.0116e-28f)); }
                    acc[ai][bj][m][0] = acc[ai][bj][m][0] * (a0 * b0); acc[ai][bj][m][1] = acc[ai][bj][m][1] * (a1 * b1); }
    }
    __device__ __forceinline__ void operator()(AccRef acc, const Unit& u, int wr, int wc, int fr, int fq) const {
        const int row0 = u.pm * BM + wr * 64 + fr, col0 = u.pn * BM + wc * 32 + 8 * fq;
        const int ln = fr + 16 * fq, bpa = DEAL_SRC(ln), rowd = u.pm * BM + wr * 64 + (ln >> 2), cold = u.pn * BM + wc * 32 + 8 * (ln & 3);
        u32x2 gb[2][4][2];
#pragma unroll
        for (int ai = 0; ai < 2; ++ai)
#pragma unroll
            for (int m = 0; m < 4; ++m) { const size_t row = (size_t)(row0 + ai * HALF + m * 16);
#pragma unroll
                for (int bj = 0; bj < 2; ++bj) gb[ai][m][bj] = *(const u32x2*)(gate + row * 2048 + 1024 + col0 + bj * HALF); }
#pragma unroll
        for (int ai = 0; ai < 2; ++ai)
#pragma unroll
            for (int m = 0; m < 4; ++m)
#pragma unroll
                for (int bj = 0; bj < 2; ++bj) { const u32x2 b = gb[ai][m][bj];
                    f32x4 b0 = ub4(b.x), b1 = ub4(b.y);
#pragma unroll
                    for (int e = 0; e < 4; ++e) { b0[e] = fmaxf(b0[e], 2.0116e-28f) * (1.0f / 255.0f); b1[e] = fmaxf(b1[e], 2.0116e-28f) * (1.0f / 255.0f); }
                    EPST(mrg + (size_t)(rowd + ai * HALF + m * 16) * 1024 + cold + bj * HALF, deal4(pack8(acc[ai][bj][m][0] * b0, acc[ai][bj][m][1] * b1), bpa)); }
    }
};
struct EpiAtt {
    static constexpr bool TAB = false;
    static constexpr bool PERM = true; static constexpr int MIDT = 0, NST = 16;
    const float* x; bf16_t* x1;
    __device__ __forceinline__ void operator()(AccRef acc, const Unit& u, int wr, int wc, int fr, int fq) const {
        const int row0 = u.pm * BM + wr * 64 + fr, col0 = u.pn * BM + wc * 32 + 8 * fq;
        const int ln = fr + 16 * fq, bpa = DEAL_SRC(ln), rowd = u.pm * BM + wr * 64 + (ln >> 2), cold = u.pn * BM + wc * 32 + 8 * (ln & 3);
#pragma unroll
        for (int ai = 0; ai < 2; ++ai) {
            f32x4 xv[4][2][2];
#pragma unroll
            for (int m = 0; m < 4; ++m) { const float* xp = x + (size_t)(row0 + ai * HALF + m * 16) * DM + col0;
#pragma unroll
                for (int bj = 0; bj < 2; ++bj) { xv[m][bj][0] = *(const f32x4*)(xp + bj * HALF); xv[m][bj][1] = *(const f32x4*)(xp + bj * HALF + 4); } }
            asm volatile("" ::: "memory");
#pragma unroll
            for (int m = 0; m < 4; ++m) { bf16_t* rowp = x1 + (size_t)(rowd + ai * HALF + m * 16) * DM + cold;
#pragma unroll
                for (int bj = 0; bj < 2; ++bj) EPST(rowp + bj * HALF, deal4(pack8(acc[ai][bj][m][0] + xv[m][bj][0], acc[ai][bj][m][1] + xv[m][bj][1]), bpa)); }
            asm volatile("" ::: "memory");
        }
    }
};
struct EpiSwiglu {
    static constexpr int PERM = 2; static constexpr int MIDT = 0, NST = 4; static constexpr bool TAB = true;
    const float* bgu; unsigned char* mid; const float* rstds; const LAS int* ecnt;
    __device__ __forceinline__ void tab_dma(const Unit& u, unsigned ldst, int wid, int lane) const {
        if (wid == 0) { const float* bg = bgu + (size_t)u.e * 2048 + u.pn * HALF + lane;
            glds4w(bg, ldst); glds4w(bg + 64, ldst + 256); glds4w(bg + 1024, ldst + 512); glds4w(bg + 1088, ldst + 768); }
        else if (wid == 1) {
#pragma unroll
            for (int j = 0; j < 4; ++j) { const int pos = u.mt * BM + 64 * j + lane; glds4w(rstds + (size_t)u.e * ECAP + (pos < u.cnt ? pos : 0), ldst + 1024 + 256 * j); } }
    }
    __device__ __forceinline__ void operator()(AccRef acc, const Unit& u, int wr, int wc, int fr, int fq, const LAS float* tab) const {
        const int cq = wc * 32 + 16 * (fq & 1) + 8 * (fq >> 1);
        f32x4 bgv[2], buv[2];
#pragma unroll
        for (int n = 0; n < 2; ++n) { bgv[n] = *(const LAS f32x4*)(tab + cq + 4 * n); buv[n] = *(const LAS f32x4*)(tab + 128 + cq + 4 * n); }
        float rsv[2][4];
#pragma unroll
        for (int ai = 0; ai < 2; ++ai)
#pragma unroll
            for (int m = 0; m < 4; ++m) rsv[ai][m] = tab[256 + ai * HALF + wr * 64 + m * 16 + fr];
        unsigned char* const sp = mid + (size_t)(u.pm * BM + wr * 64 + fr + 16 * (fq >> 1)) * 1024 + u.pn * HALF + wc * 32 + 16 * (fq & 1);
#pragma unroll
        for (int ai = 0; ai < 2; ++ai)
#pragma unroll
            for (int mp = 0; mp < 2; ++mp) { u32x2 w[2];
#pragma unroll
                for (int mm = 0; mm < 2; ++mm) { const int m = 2 * mp + mm; f32x4 o[2];
                    const float rs = rsv[ai][m];
#pragma unroll
                    for (int n = 0; n < 2; ++n) { const f32x4 g = acc[ai][0][m][n] * rs + bgv[n], uu = acc[ai][1][m][n] * rs + buv[n];
#pragma unroll
                        for (int e2 = 0; e2 < 2; ++e2) {
                            f32x2 gg = {fminf(g[2 * e2], 7.0f), fminf(g[2 * e2 + 1], 7.0f)};
                            f32x2 uc = {__builtin_amdgcn_fmed3f(uu[2 * e2], -7.0f, 7.0f), __builtin_amdgcn_fmed3f(uu[2 * e2 + 1], -7.0f, 7.0f)};
                            const f32x2 ea = gg * (-1.702f * LOG2E);
                            f32x2 ex = {__builtin_amdgcn_exp2f(ea.x), __builtin_amdgcn_exp2f(ea.y)};
                            const f32x2 dn = ex + 1.0f;
                            f32x2 rc = {__builtin_amdgcn_rcpf(dn.x), __builtin_amdgcn_rcpf(dn.y)};
                            const f32x2 r2 = (uc * SC_MID + SC_MID) * (gg * rc);
                            o[n][2 * e2] = r2.x; o[n][2 * e2 + 1] = r2.y; } }
                    w[mm].x = pk4_fp8(o[0][0], o[0][1], o[0][2], o[0][3]); w[mm].y = pk4_fp8(o[1][0], o[1][1], o[1][2], o[1][3]); }
                EPST(sp + (size_t)(ai * HALF + mp * 32) * 1024, pair_rows(w[0], w[1])); }
    }
};
struct EpiDown {
    static constexpr int PERM = 2; static constexpr int MIDT = 0, NST = 8; static constexpr bool TAB = true;
    const float* bd; const float* rgate; unsigned char* Y; const LAS int* ecnt;
    __device__ __forceinline__ void tab_dma(const Unit& u, unsigned ldst, int wid, int lane) const {
        if (wid == 0) { const float* b = bd + (size_t)u.e * 1024 + u.pn * BM + lane;
            glds4w(b, ldst); glds4w(b + 64, ldst + 256); glds4w(b + 128, ldst + 512); glds4w(b + 192, ldst + 768); }
        else if (wid == 1) {
#pragma unroll
            for (int j = 0; j < 4; ++j) { const int pos = u.mt * BM + 64 * j + lane; glds4w(rgate + (size_t)u.e * ECAP + (pos < u.cnt ? pos : 0), ldst + 1024 + 256 * j); } }
    }
    __device__ __forceinline__ void operator()(AccRef acc, const Unit& u, int wr, int wc, int fr, int fq, const LAS float* tab) const {
        const int cq = wc * 32 + 16 * (fq & 1) + 8 * (fq >> 1), cnt = u.cnt;
        f32x4 bv[2][2];
#pragma unroll
        for (int bj = 0; bj < 2; ++bj)
#pragma unroll
            for (int n = 0; n < 2; ++n) bv[bj][n] = *(const LAS f32x4*)(tab + cq + bj * HALF + 4 * n);
        float wv[2][4];
#pragma unroll
        for (int ai = 0; ai < 2; ++ai)
#pragma unroll
            for (int m = 0; m < 4; ++m) { const int r_ = ai * HALF + wr * 64 + m * 16 + fr; const float t = tab[256 + r_]; wv[ai][m] = (u.mt * BM + r_ < cnt) ? t * SC_Y : 0.f; }
        unsigned char* const sp = Y + (size_t)(u.pm * BM + wr * 64 + fr + 16 * (fq >> 1)) * 1024 + u.pn * BM + wc * 32 + 16 * (fq & 1);
#pragma unroll
        for (int ai = 0; ai < 2; ++ai)
#pragma unroll
            for (int mp = 0; mp < 2; ++mp)
#pragma unroll
                for (int bj = 0; bj < 2; ++bj) { u32x2 o[2];
#pragma unroll
                    for (int mm = 0; mm < 2; ++mm) { const int m = 2 * mp + mm; const float w = wv[ai][m];
                        const f32x4 v0 = (acc[ai][bj][m][0] + bv[bj][0]) * w, v1 = (acc[ai][bj][m][1] + bv[bj][1]) * w;
                        o[mm].x = pk4_fp8s(v0[0], v0[1], v0[2], v0[3]); o[mm].y = pk4_fp8s(v1[0], v1[1], v1[2], v1[3]); }
                    EPST(sp + (size_t)(ai * HALF + mp * 32) * 1024 + bj * HALF, pair_rows(o[0], o[1])); }
    }
};
}

namespace att {
using bf16 = __hip_bfloat16;
constexpr int NW = 8, QBLK = 32, QB = QBLK * NW, KVBLK = 64;
__device__ __forceinline__ int crow(int r, int hi) { return (r & 3) + 8 * (r >> 2) + 4 * hi; }
__device__ __forceinline__ f32x16 splat16(float z) { return (f32x16){z, z, z, z, z, z, z, z, z, z, z, z, z, z, z, z}; }
#define SBAR() __builtin_amdgcn_sched_barrier(0)
__device__ __forceinline__ void cmask(f32x16& p0, f32x16& p1, int jb, int qrel, int hi) {
    const float NEG = -INFINITY; int kb = 64 * jb + 4 * hi;
#pragma unroll
    for (int r = 0; r < 16; ++r) { int kv = kb + (r & 3) + 8 * (r >> 2); if (kv > qrel) p0[r] = NEG; if (kv + 32 > qrel) p1[r] = NEG; }
}
constexpr int NSLOT = 3, SLOTB = 8192;
constexpr int LDS_K = 0, LDS_V = NSLOT * SLOTB, LDS_WS = 2 * NSLOT * SLOTB, LDS_OST = LDS_WS + NW * 64 * 4, LDS_KB = LDS_OST + NW * 4096, LDS_T0 = LDS_KB + SEQ * 4, LDS_BYTES = LDS_T0 + 16;
__device__ __forceinline__ void glds16(const void* gsrc, unsigned lds_dst) { unsigned keep;
    asm volatile("s_mov_b32 %0, m0\n\ts_mov_b32 m0, %2\n\ts_nop 0\n\tglobal_load_lds_dwordx4 %1, off\n\ts_mov_b32 m0, %0" : "=&s"(keep) : "v"(gsrc), "s"(lds_dst) : "memory"); }
__device__ __forceinline__ float max3f(float a, float b, float c) { float r; asm("v_max3_f32 %0, %1, %2, %3" : "=v"(r) : "v"(a), "v"(b), "v"(c)); return r; }
__device__ __forceinline__ float max2f(float a, float b) { float r; asm("v_max_f32_e32 %0, %1, %2" : "=v"(r) : "v"(a), "v"(b)); return r; }
__device__ __forceinline__ float fadd_s(float a, float b) { float r; asm("v_add_f32_e32 %0, %1, %2" : "=v"(r) : "v"(a), "v"(b)); return r; }
__device__ __forceinline__ float fsub_s(float a, float b) { float r; asm("v_sub_f32_e32 %0, %1, %2" : "=v"(r) : "v"(a), "v"(b)); return r; }
typedef __bf16 bf16x2_t __attribute__((ext_vector_type(2)));
__device__ __forceinline__ unsigned cvtpk_s(float lo, float hi) { f32x2 v = {lo, hi}; bf16x2_t b = __builtin_convertvector(v, bf16x2_t); return __builtin_bit_cast(unsigned, b); }
#define WAIT_BAR(N) asm volatile("s_waitcnt vmcnt(" #N ") lgkmcnt(0)\n\ts_barrier" ::: "memory")
__device__ __forceinline__ void qkt(f32x16& p0, f32x16& p1, const char* Kslot, const bf16x8* qr, const f32x16& cinit, int r32, int hi) {
    const char* kb = Kslot + hi * 1024 + r32 * 16;
#pragma unroll
    for (int d0 = 0; d0 < 4; ++d0) {
        const bf16x8 b0 = *reinterpret_cast<const bf16x8*>(kb + d0 * 2048);
        const bf16x8 b1 = *reinterpret_cast<const bf16x8*>(kb + d0 * 2048 + 512);
        if (d0 == 0) { p0 = __builtin_amdgcn_mfma_f32_32x32x16_bf16(b0, qr[0], cinit, 0, 0, 0); p1 = __builtin_amdgcn_mfma_f32_32x32x16_bf16(b1, qr[0], cinit, 0, 0, 0); }
        else { p0 = __builtin_amdgcn_mfma_f32_32x32x16_bf16(b0, qr[d0], p0, 0, 0, 0); p1 = __builtin_amdgcn_mfma_f32_32x32x16_bf16(b1, qr[d0], p1, 0, 0, 0); } }
}
template <int H> __device__ __forceinline__ void qkt_half(f32x16& p, const char* Kslot, const bf16x8* qr, const f32x16& cinit, int r32, int hi) {
    const char* kb = Kslot + hi * 1024 + r32 * 16 + H * 512;
#pragma unroll
    for (int d0 = 0; d0 < 4; ++d0) { const bf16x8 b = *reinterpret_cast<const bf16x8*>(kb + d0 * 2048);
        p = __builtin_amdgcn_mfma_f32_32x32x16_bf16(b, qr[d0], d0 == 0 ? cinit : p, 0, 0, 0); }
}
typedef LAS const char* lds_cptr;
typedef short v4i16_t __attribute__((ext_vector_type(4)));
__device__ __forceinline__ void kload8(bf16x8* kf, lds_cptr kp) {
    kf[0] = *(const LAS bf16x8*)(kp);        kf[1] = *(const LAS bf16x8*)(kp + 512);
    kf[2] = *(const LAS bf16x8*)(kp + 2048); kf[3] = *(const LAS bf16x8*)(kp + 2560);
    kf[4] = *(const LAS bf16x8*)(kp + 4096); kf[5] = *(const LAS bf16x8*)(kp + 4608);
    kf[6] = *(const LAS bf16x8*)(kp + 6144); kf[7] = *(const LAS bf16x8*)(kp + 6656);
}
__device__ __forceinline__ void kload2(bf16x8* kf, lds_cptr kp, int j) { kf[2 * j] = *(const LAS bf16x8*)(kp + j * 2048); kf[2 * j + 1] = *(const LAS bf16x8*)(kp + j * 2048 + 512); }
__device__ __forceinline__ s16x4 vtr(lds_cptr p) { return __builtin_bit_cast(s16x4, __builtin_amdgcn_ds_read_tr16_b64_v4i16((LAS v4i16_t*)p)); }
__device__ __forceinline__ float rowmax(const f32x16& p0, const f32x16& p1) {
    float a = max3f(p0[0], p0[1], p1[0]), b = max3f(p0[2], p0[3], p1[1]); a = max3f(a, p1[2], p1[3]);
#pragma unroll
    for (int r = 4; r < 16; r += 4) { a = max3f(a, p0[r], p0[r + 1]); b = max3f(b, p0[r + 2], p0[r + 3]); a = max3f(a, p1[r], p1[r + 1]); b = max3f(b, p1[r + 2], p1[r + 3]); }
    const float m = max2f(a, b);
    auto rr = __builtin_amdgcn_permlane32_swap(__float_as_uint(m), __float_as_uint(m), false, false);
    return max2f(__uint_as_float(rr[0]), __uint_as_float(rr[1]));
}
__device__ __forceinline__ void pv(f32x16* o, int vb, bf16x8 pa0, bf16x8 pa1, bf16x8 pa2, bf16x8 pa3) {
#pragma unroll
    for (int d0 = 0; d0 < 2; ++d0) { s16x4 lo[4], hi[4];
#pragma unroll
        for (int ks = 0; ks < 4; ++ks) {
            asm volatile("ds_read_b64_tr_b16 %0,%1 offset:%c2" : "=&v"(lo[ks]) : "v"(vb), "i"(d0 * 4096 + ks * 1024) : "memory");
            asm volatile("ds_read_b64_tr_b16 %0,%1 offset:%c2" : "=&v"(hi[ks]) : "v"(vb), "i"(d0 * 4096 + ks * 1024 + 512) : "memory"); }
        asm volatile("s_waitcnt lgkmcnt(0)" ::: "memory"); SBAR();
#define PK(k) (bf16x8){lo[k][0], lo[k][1], lo[k][2], lo[k][3], hi[k][0], hi[k][1], hi[k][2], hi[k][3]}
        o[d0] = __builtin_amdgcn_mfma_f32_32x32x16_bf16(pa0, PK(0), o[d0], 0, 0, 0);
        o[d0] = __builtin_amdgcn_mfma_f32_32x32x16_bf16(pa1, PK(1), o[d0], 0, 0, 0);
        o[d0] = __builtin_amdgcn_mfma_f32_32x32x16_bf16(pa2, PK(2), o[d0], 0, 0, 0);
        o[d0] = __builtin_amdgcn_mfma_f32_32x32x16_bf16(pa3, PK(3), o[d0], 0, 0, 0);
#undef PK
    }
}
template <int H> __device__ __forceinline__ void pv_half(f32x16* o, int vb, bf16x8 pa0, bf16x8 pa1) {
#pragma unroll
    for (int d0 = 0; d0 < 2; ++d0) { s16x4 lo[2], hi[2];
#pragma unroll
        for (int ks = 0; ks < 2; ++ks) {
            asm volatile("ds_read_b64_tr_b16 %0,%1 offset:%c2" : "=&v"(lo[ks]) : "v"(vb), "i"(d0 * 4096 + (2 * H + ks) * 1024) : "memory");
            asm volatile("ds_read_b64_tr_b16 %0,%1 offset:%c2" : "=&v"(hi[ks]) : "v"(vb), "i"(d0 * 4096 + (2 * H + ks) * 1024 + 512) : "memory"); }
        asm volatile("s_waitcnt lgkmcnt(0)" ::: "memory"); SBAR();
#define PK(k) (bf16x8){lo[k][0], lo[k][1], lo[k][2], lo[k][3], hi[k][0], hi[k][1], hi[k][2], hi[k][3]}
        o[d0] = __builtin_amdgcn_mfma_f32_32x32x16_bf16(pa0, PK(0), o[d0], 0, 0, 0);
        o[d0] = __builtin_amdgcn_mfma_f32_32x32x16_bf16(pa1, PK(1), o[d0], 0, 0, 0);
#undef PK
    }
}
#define KADD(C0, C1, t) do { const LAS f32x4* kp_ = (const LAS f32x4*)(kbl + 64 * (t) + 4 * hi); \
    _Pragma("unroll") for (int j_ = 0; j_ < 4; ++j_) { const f32x4 a_ = kp_[2 * j_] - mhat, b_ = kp_[8 + 2 * j_] - mhat; \
      C0[4 * j_] += a_[0]; C0[4 * j_ + 1] += a_[1]; C0[4 * j_ + 2] += a_[2]; C0[4 * j_ + 3] += a_[3]; \
      C1[4 * j_] += b_[0]; C1[4 * j_ + 1] += b_[1]; C1[4 * j_ + 2] += b_[2]; C1[4 * j_ + 3] += b_[3]; } } while (0)

template <int THRL> __device__ __forceinline__ void fox_unit(int b, int h, int qb, const bf16* Q, const bf16* __restrict__ K, const bf16* __restrict__ V, bf16* O, const float* cbl, float Tthr, char* shm, unsigned* qhead, LAS int* qslot) {
    constexpr int PIT = BW;
    int tid = threadIdx.x; asm volatile("" : "+v"(tid));
    float zf = 0.f; asm volatile("" : "+v"(zf));
    const int lane = tid & 63, r32 = lane & 31, hi = lane >> 5; const int wid = __builtin_amdgcn_readfirstlane(tid >> 6);
    const long rowbase = (long)b * SEQ; const int q0 = qb * QB;
    const bf16* Qw = Q + (rowbase + q0 + wid * QBLK) * PIT + h * 64;
    const bf16* Kh = K + rowbase * PIT + h * 64, *Vh = V + rowbase * PIT + h * 64;
    const unsigned lds0 = (unsigned)(uintptr_t)shm;
    float* wsf = (float*)(shm + LDS_WS) + wid * 64;
    const LAS float* kbl = (const LAS float*)((lds_cptr)shm + LDS_KB);
    const bf16* ksrc = Kh + (long)lane * PIT + wid * 8;
    const bf16* vsrc = Vh + (long)(16 * (wid & 3) + (lane >> 2)) * PIT + (wid >> 2) * 32 + (lane & 3) * 8;
    int NT = (q0 + QB) / KVBLK;
    const unsigned kdst = lds0 + LDS_K + wid * 1024, vdst = lds0 + LDS_V + wid * 1024;
#define DMA_K(t, slot) glds16(ksrc + (long)(t) * KVBLK * PIT, (unsigned)__builtin_amdgcn_readfirstlane(kdst + (slot)))
#define DMA_V(t, slot) glds16(vsrc + (long)(t) * KVBLK * PIT, (unsigned)__builtin_amdgcn_readfirstlane(vdst + (slot)))
    const int vb0 = (int)(lds0 + LDS_V) + ((lane >> 4) & 1) * 32 + (lane & 3) * 8 + (4 * hi + ((lane & 15) >> 2)) * 64;
    const char* Kbase = shm + LDS_K; bf16x8 kf[8];
    const lds_cptr shm3 = (lds_cptr)shm; const lds_cptr kp0 = shm3 + LDS_K + hi * 1024 + r32 * 16; const lds_cptr vp0 = shm3 + LDS_V + ((lane >> 4) & 1) * 32 + (lane & 3) * 8 + (4 * hi + ((lane & 15) >> 2)) * 64;
    { const float* cb = cbl + (size_t)(b * 8 + h) * SEQ; LAS float* kw = (LAS float*)((lds_cptr)shm + LDS_KB); const int nmax = q0 + QB;
      const float cref = cb[q0]; const float c63 = cb[64 * (lane < NT ? lane : NT - 1) + 63];
      float tv[8];
#pragma unroll
      for (int i = 0; i < 8; ++i) { const int sidx = tid + NW * 64 * i; tv[i] = cb[sidx < nmax ? sidx : nmax - 1]; }
      const bool skip = (lane < NT) && (cref - c63 <= -Tthr);
      int ts = (int)__popcll(__ballot(skip)) & ~1; ts = ts < NT - 4 ? ts : NT - 4;
      const int t0 = __builtin_amdgcn_readfirstlane(ts);
      ksrc += (long)t0 * KVBLK * PIT; vsrc += (long)t0 * KVBLK * PIT; kbl += 64 * t0; NT -= t0;
      DMA_K(0, 0); DMA_V(0, 0); DMA_K(1, SLOTB);
#pragma unroll
      for (int i = 0; i < 8; ++i) { const int sidx = tid + NW * 64 * i; if (sidx < nmax) kw[sidx] = cref - tv[i]; } }
    bf16x8 qr[4];
#pragma unroll
    for (int d0 = 0; d0 < 4; ++d0) qr[d0] = *reinterpret_cast<const bf16x8*>(&Qw[(long)r32 * PIT + d0 * 16 + hi * 8]);
    float mhat = zf, l_reg = zf; f32x16 o[2]; o[0] = splat16(zf); o[1] = splat16(zf); const f32x16 zero16 = splat16(0.f);
    const int qrel = wid * QBLK + r32;
#define CMASK(P0, P1, t) do { int jb_ = (t) - (NT - 4); if (jb_ >= 0) cmask(P0, P1, jb_, qrel, hi); } while (0)
    bool resc = false;
#define START(P0, P1) do { const float rm = rowmax(P0, P1); resc = false; \
    { const float dl = rm; mhat = fadd_s(mhat, dl); \
      _Pragma("unroll") for (int r = 0; r < 16; ++r) { P0[r] = fsub_s(P0[r], dl); P1[r] = fsub_s(P1[r], dl); } } \
    _Pragma("unroll") for (int r = 0; r < 16; ++r) P0[r] = __builtin_amdgcn_exp2f(P0[r]); } while (0)
#define RESC() do { if (resc) { asm volatile("s_waitcnt lgkmcnt(0)" ::: "memory"); \
      _Pragma("unroll") for (int d_ = 0; d_ < 2; ++d_) _Pragma("unroll") for (int r = 0; r < 16; ++r) o[d_][r] *= wsf[crow(r, hi)]; } } while (0)
    f32x16 pA0, pA1, pB0, pB1;
    int sl_prev = 0, sl_cur = 0, sl_next = SLOTB;
#define ROT() do { sl_prev = sl_cur; sl_cur = sl_next; sl_next = (sl_next == (NSLOT - 1) * SLOTB) ? 0 : sl_next + SLOTB; } while (0)
    DMA_K(2, 2 * SLOTB);
    WAIT_BAR(3);
    qkt(pA0, pA1, Kbase, qr, zero16, r32, hi); KADD(pA0, pA1, 0); asm volatile("s_nop 15\n\ts_nop 7" : "+v"(pA0), "+v"(pA1)); CMASK(pA0, pA1, 0);
    START(pA0, pA1);
    _Pragma("unroll") for (int r = 0; r < 16; ++r) pA1[r] = __builtin_amdgcn_exp2f(pA1[r]);
    WAIT_BAR(0);
    DMA_K(3, 0); DMA_V(1, SLOTB);
    ROT();
    kload8(kf, kp0 + sl_cur);
    WAIT_BAR(2);
    s16x4 vlo[8], vhi[8]; u32x4 pw0, pw1, pw2, pw3;
#define PKW(P, B) cvtpk_s(P[B], P[B + 1])
#define PAF(k) __builtin_bit_cast(bf16x8, pw##k)
#define VFR(i) (bf16x8){vlo[i][0], vlo[i][1], vlo[i][2], vlo[i][3], vhi[i][0], vhi[i][1], vhi[i][2], vhi[i][3]}
#define PIN(x) asm volatile("" : "+v"(x))
#define MX3(a, b, c) __builtin_fmaxf(__builtin_fmaxf((a), (b)), (c))
#define GAPA(MF, A0, A1, A2, A3, W0, W1, PW) do { MF; sacc += A0; sacc += A1; sacc += A2; sacc += A3; PIN(sacc); W0; W1; PIN(PW); SBAR(); } while (0)
#define EX(v) __builtin_amdgcn_exp2f(v)
#define GAPB(MF, X, B) do { MF; X[B] = EX(X[B]); X[B + 1] = EX(X[B + 1]); X[B + 2] = EX(X[B + 2]); X[B + 3] = EX(X[B + 3]); PIN(X); SBAR(); } while (0)
#define VRD(i) do { vlo[i] = vtr(vp_ + (((i) >> 2) * 4096 + ((i) & 3) * 1024)); vhi[i] = vtr(vp_ + (((i) >> 2) * 4096 + ((i) & 3) * 1024 + 512)); } while (0)
#define KRD(G, j) do { if (G) { kload2(kf, kp0 + sl_next, j); SBAR(); } } while (0)
#define STEP(C0, C1, P0, P1, t, GK, GV, GL) do { SBAR(); \
    const lds_cptr vp_ = vp0 + sl_prev; \
    VRD(0); SBAR(); float sacc = (P0[0] + P0[1]); \
    GAPA(C0 = __builtin_amdgcn_mfma_f32_32x32x16_bf16(kf[0], qr[0], zero16, 0, 0, 0), P0[2], P0[3], P0[4], P0[5],     pw0[0] = PKW(P0, 0), pw0[1] = PKW(P0, 2), pw0); \
    VRD(4); SBAR(); GAPA(C1 = __builtin_amdgcn_mfma_f32_32x32x16_bf16(kf[1], qr[0], zero16, 0, 0, 0), P0[6], P0[7], P0[8], P0[9],     pw0[2] = PKW(P0, 4), pw0[3] = PKW(P0, 6), pw0); \
    VRD(1); SBAR(); GAPA(C0 = __builtin_amdgcn_mfma_f32_32x32x16_bf16(kf[2], qr[1], C0, 0, 0, 0),   P0[10], P0[11], P0[12], P0[13], pw1[0] = PKW(P0, 8), pw1[1] = PKW(P0, 10), pw1); \
    VRD(5); SBAR(); GAPA(C1 = __builtin_amdgcn_mfma_f32_32x32x16_bf16(kf[3], qr[1], C1, 0, 0, 0),   P0[14], P0[15], P1[0], P1[1],   pw1[2] = PKW(P0, 12), pw1[3] = PKW(P0, 14), pw1); \
    VRD(2); SBAR(); GAPA(C0 = __builtin_amdgcn_mfma_f32_32x32x16_bf16(kf[4], qr[2], C0, 0, 0, 0),   P1[2], P1[3], P1[4], P1[5],     pw2[0] = PKW(P1, 0), pw2[1] = PKW(P1, 2), pw2); \
    VRD(6); SBAR(); GAPA(C1 = __builtin_amdgcn_mfma_f32_32x32x16_bf16(kf[5], qr[2], C1, 0, 0, 0),   P1[6], P1[7], P1[8], P1[9],     pw2[2] = PKW(P1, 4), pw2[3] = PKW(P1, 6), pw2); \
    VRD(3); SBAR(); GAPA(C0 = __builtin_amdgcn_mfma_f32_32x32x16_bf16(kf[6], qr[3], C0, 0, 0, 0),   P1[10], P1[11], P1[12], P1[13], pw3[0] = PKW(P1, 8), pw3[1] = PKW(P1, 10), pw3); \
    VRD(7); SBAR(); GAPA(C1 = __builtin_amdgcn_mfma_f32_32x32x16_bf16(kf[7], qr[3], C1, 0, 0, 0),   P1[14], P1[15], 0.f, 0.f,       pw3[2] = PKW(P1, 12), pw3[3] = PKW(P1, 14), pw3); \
    l_reg += sacc; \
    if (GK) { DMA_K((t) + 3, sl_cur); } if (GV) { DMA_V((t) + 1, sl_next); } \
    KADD(C0, C1, t); \
    CMASK(C0, C1, t); \
    { float a = MX3(C0[0], C0[1], C1[0]), b = MX3(C0[2], C0[3], C1[1]); a = MX3(a, C1[2], C1[3]); \
      _Pragma("unroll") for (int r = 4; r < 16; r += 4) { a = MX3(a, C0[r], C0[r + 1]); b = MX3(b, C0[r + 2], C0[r + 3]); a = MX3(a, C1[r], C1[r + 1]); b = MX3(b, C1[r + 2], C1[r + 3]); } \
      float rm = __builtin_fmaxf(a, b); { auto rr = __builtin_amdgcn_permlane32_swap(__float_as_uint(rm), __float_as_uint(rm), false, false); rm = __builtin_fmaxf(__uint_as_float(rr[0]), __uint_as_float(rr[1])); } \
      resc = false; \
      if (__builtin_expect(__any(rm > (float)THRL), 0)) { const float dl = __builtin_fmaxf(rm, 0.f); mhat += dl; \
        _Pragma("unroll") for (int r = 0; r < 16; ++r) { C0[r] -= dl; C1[r] -= dl; } \
        const float f = __builtin_amdgcn_exp2f(-dl); l_reg *= f; if (hi == 0) wsf[r32] = f; resc = true; } } \
    SBAR(); \
    GAPB(o[0] = __builtin_amdgcn_mfma_f32_32x32x16_bf16(PAF(0), VFR(0), o[0], 0, 0, 0), C0, 0); \
    GAPB(o[1] = __builtin_amdgcn_mfma_f32_32x32x16_bf16(PAF(0), VFR(4), o[1], 0, 0, 0), C0, 4); \
    KRD(GL, 0); GAPB(o[0] = __builtin_amdgcn_mfma_f32_32x32x16_bf16(PAF(1), VFR(1), o[0], 0, 0, 0), C0, 8); \
    KRD(GL, 1); GAPB(o[1] = __builtin_amdgcn_mfma_f32_32x32x16_bf16(PAF(1), VFR(5), o[1], 0, 0, 0), C0, 12); \
    KRD(GL, 2); GAPB(o[0] = __builtin_amdgcn_mfma_f32_32x32x16_bf16(PAF(2), VFR(2), o[0], 0, 0, 0), C1, 0); \
    KRD(GL, 3); GAPB(o[1] = __builtin_amdgcn_mfma_f32_32x32x16_bf16(PAF(2), VFR(6), o[1], 0, 0, 0), C1, 4); \
    GAPB(o[0] = __builtin_amdgcn_mfma_f32_32x32x16_bf16(PAF(3), VFR(3), o[0], 0, 0, 0), C1, 8); \
    GAPB(o[1] = __builtin_amdgcn_mfma_f32_32x32x16_bf16(PAF(3), VFR(7), o[1], 0, 0, 0), C1, 12); \
    } while (0)
    int t = 1;
#undef CMASK
#define CMASK(P0, P1, t) do {} while (0)
    for (; t + 5 < NT; t += 2) {
        STEP(pB0, pB1, pA0, pA1, t, true, true, true);     WAIT_BAR(2); RESC(); ROT();
        STEP(pA0, pA1, pB0, pB1, t + 1, true, true, true); WAIT_BAR(2); RESC(); ROT();
    }
#undef CMASK
#define CMASK(P0, P1, t) do { int jb_ = (t) - (NT - 4); if (jb_ >= 0) cmask(P0, P1, jb_, qrel, hi); } while (0)
#define ENDW(tt) do { if ((tt) + 3 < NT) { WAIT_BAR(2); } else if ((tt) + 2 < NT) { WAIT_BAR(1); } else { WAIT_BAR(0); } } while (0)
    for (; t + 1 < NT; t += 2) {
        STEP(pB0, pB1, pA0, pA1, t, (t + 3 < NT), (t + 1 < NT), (t + 1 < NT));         ENDW(t);     RESC(); ROT();
        STEP(pA0, pA1, pB0, pB1, t + 1, (t + 4 < NT), (t + 2 < NT), (t + 2 < NT));     ENDW(t + 1); RESC(); ROT();
    }
    int nxv = 0; if (tid == 0) nxv = 1536 + (int)__hip_atomic_fetch_add(qhead, 1u, __ATOMIC_RELAXED, __HIP_MEMORY_SCOPE_AGENT);
    STEP(pB0, pB1, pA0, pA1, NT - 1, false, false, false); RESC();
    { float sacc = pB0[0] + pB0[1]; _Pragma("unroll") for (int r = 2; r < 16; ++r) sacc += pB0[r]; _Pragma("unroll") for (int r = 0; r < 16; ++r) sacc += pB1[r]; l_reg += sacc;
      pw0 = (u32x4){PKW(pB0, 0), PKW(pB0, 2), PKW(pB0, 4), PKW(pB0, 6)}; pw1 = (u32x4){PKW(pB0, 8), PKW(pB0, 10), PKW(pB0, 12), PKW(pB0, 14)}; pw2 = (u32x4){PKW(pB1, 0), PKW(pB1, 2), PKW(pB1, 4), PKW(pB1, 6)}; pw3 = (u32x4){PKW(pB1, 8), PKW(pB1, 10), PKW(pB1, 12), PKW(pB1, 14)};
      SBAR(); pv(o, vb0 + sl_cur, PAF(0), PAF(1), PAF(2), PAF(3)); }
#undef GAPA
#undef GAPB
#undef EX
#undef VRD
#undef KRD
#undef STEP
#undef ENDW
    { auto rr = __builtin_amdgcn_permlane32_swap(__float_as_uint(l_reg), __float_as_uint(l_reg), false, false); l_reg = __uint_as_float(rr[0]) + __uint_as_float(rr[1]); }
    if (hi == 0) wsf[32 + r32] = l_reg; asm volatile("s_waitcnt lgkmcnt(0)" ::: "memory");
    float rli[16];
#pragma unroll
    for (int r = 0; r < 16; ++r) rli[r] = __builtin_amdgcn_rcpf(wsf[32 + crow(r, hi)]);
    bf16* Ow = O + (rowbase + q0 + wid * QBLK) * OABP + OAW + h * 64;
    { bf16* stg = (bf16*)(shm + LDS_OST) + wid * 2048;
#pragma unroll
      for (int r = 0; r < 16; ++r) { const int orow = crow(r, hi);
#pragma unroll
          for (int d0 = 0; d0 < 2; ++d0) stg[orow * 64 + d0 * 32 + r32] = __float2bfloat16(o[d0][r] * rli[r]); }
      asm volatile("s_waitcnt lgkmcnt(0)" ::: "memory");
#pragma unroll
      for (int i = 0; i < 4; ++i) { const int row = i * 8 + (lane >> 3), ch = lane & 7; const u32x4 v = *(const u32x4*)(stg + row * 64 + ch * 8); *(u32x4*)(Ow + (long)row * OABP + ch * 8) = v; } }
    if (tid == 0) *qslot = nxv;
    asm volatile("s_waitcnt lgkmcnt(0)\n\ts_barrier" ::: "memory");
#undef DMA_K
#undef DMA_V
#undef CMASK
#undef START
#undef RESC
#undef ROT
}

constexpr int DS_K = 0, DS_V = 6 * SLOTB, DS_OST = 12 * SLOTB;
__device__ const unsigned char T5_BUCKET[3][129] = {
 {0,1,2,3,4,5,6,7,8,9,10,11,12,13,14,15,16,16,16,16,16,16,17,17,17,17,17,17,17,17,18,18,18,18,18,18,18,18,18,18,19,19,19,19,19,19,19,19,19,19,19,19,19,19,20,20,20,20,20,20,20,20,20,20,20,20,20,20,20,20,20,20,20,21,21,21,21,21,21,21,21,21,21,21,21,21,21,21,21,21,21,21,21,21,21,21,21,21,21,22,22,22,22,22,22,22,22,22,22,22,22,22,22,22,22,22,22,22,22,22,22,22,22,22,22,22,22,22,22},
 {0,4,8,12,16,16,17,17,18,18,19,19,19,19,20,20,20,20,20,21,21,21,21,21,21,22,22,22,22,22,22,22,22,22,23,23,23,23,23,23,23,23,23,23,23,23,24,24,24,24,24,24,24,24,24,24,24,24,24,24,24,24,25,25,25,25,25,25,25,25,25,25,25,25,25,25,25,25,25,25,25,25,25,26,26,26,26,26,26,26,26,26,26,26,26,26,26,26,26,26,26,26,26,26,26,26,26,26,26,26,26,26,26,27,27,27,27,27,27,27,27,27,27,27,27,27,27,27,27},
 {0,16,18,19,20,21,21,22,22,23,23,23,24,24,24,24,25,25,25,25,25,26,26,26,26,26,26,26,26,27,27,27,27,27,27,27,27,27,27,28,28,28,28,28,28,28,28,28,28,28,28,28,29,29,29,29,29,29,29,29,29,29,29,29,29,29,29,29,29,29,30,30,30,30,30,30,30,30,30,30,30,30,30,30,30,30,30,30,30,30,30,30,30,30,30,31,31,31,31,31,31,31,31,31,31,31,31,31,31,31,31,31,31,31,31,31,31,31,31,31,31,31,31,31,31,31,31,31,31}};
__device__ __forceinline__ void dswa_stage(bool doK, bool doV, int b, int g, int hg, int rres, int qb, const bf16* __restrict__ K, const bf16* __restrict__ V, char* shm, int wid, int lane) {
    constexpr int PIT = AW; const int d = 1 << (2 * g), head = g * 4 + hg; const long tok0 = (long)b * SEQ + rres; const int kstart = 256 * qb - 128; const unsigned lds0 = (unsigned)(uintptr_t)shm;
    const bf16* Kh = K + head * 64 + wid * 8; const bf16* Vh = V + head * 64 + (wid >> 2) * 32 + (lane & 3) * 8;
#pragma unroll
    for (int j = 0; j < 6; ++j) {
        int mk = kstart + 64 * j + lane; mk = mk < 0 ? 0 : mk;
        int mv = kstart + 64 * j + 16 * (wid & 3) + (lane >> 2); mv = mv < 0 ? 0 : mv;
        if (doK) glds16(Kh + (tok0 + (long)d * mk) * PIT, (unsigned)__builtin_amdgcn_readfirstlane(lds0 + DS_K + j * SLOTB + wid * 1024));
        if (doV) glds16(Vh + (tok0 + (long)d * mv) * PIT, (unsigned)__builtin_amdgcn_readfirstlane(lds0 + DS_V + j * SLOTB + wid * 1024)); }
}
__device__ __forceinline__ void dswa_unit(int b, int g, int hg, int rres, int qb, const bf16* Q, const bf16* __restrict__ K, const bf16* __restrict__ V, bf16* Og, float* lse, const float* rel_bias,
                                          char* shm, LAS float* lut, LAS float* wsfb, bool pre, int nb, int ng, int nhg, int nrres, int nqb, bool need_lut, bf16x8 (&qn)[4]) {
    constexpr int PIT = AW;
    int tid = threadIdx.x; asm volatile("" : "+v"(tid));
    float zf = 0.f; asm volatile("" : "+v"(zf));
    const int lane = tid & 63, r32 = lane & 31, hi = lane >> 5; const int wid = __builtin_amdgcn_readfirstlane(tid >> 6);
    const int dsh = 2 * g, d = 1 << dsh, head = g * 4 + hg;
    const long tok0 = (long)b * SEQ + rres;
    const int kstart = 256 * qb - 128;
    const unsigned lds0 = (unsigned)(uintptr_t)shm;
    if (!pre) dswa_stage(true, true, b, g, hg, rres, qb, K, V, shm, wid, lane);
    if (need_lut && tid < 256) { const int back = tid - 64; float v = -INFINITY; if (back >= 0 && back <= 128) v = rel_bias[(int)T5_BUCKET[g][back] * 12 + head] * LOG2E; lut[tid] = v; }
    const int mq0 = 256 * qb + 32 * wid;
    const bf16* Qw = Q + (tok0 + (long)d * (mq0 + r32)) * PIT + head * 64;
    bf16x8 qr[4];
    if (pre) {
#pragma unroll
        for (int d0 = 0; d0 < 4; ++d0) qr[d0] = qn[d0]; }
    else {
#pragma unroll
        for (int d0 = 0; d0 < 4; ++d0) qr[d0] = *reinterpret_cast<const bf16x8*>(&Qw[d0 * 16 + hi * 8]); }
    asm volatile("s_waitcnt vmcnt(0) lgkmcnt(0)" ::: "memory"); __syncthreads();
    const int j0 = wid >> 1;
    f32x16 p[6]; const f32x16 zero16 = splat16(zf);
    const bool oddw = wid & 1; const int tm = oddw ? 0 : 5;
    if (oddw) { p[0] = zero16; qkt_half<1>(p[1], shm + DS_K + j0 * SLOTB, qr, zero16, r32, hi); qkt(p[2], p[3], shm + DS_K + (j0 + 1) * SLOTB, qr, zero16, r32, hi); qkt(p[4], p[5], shm + DS_K + (j0 + 2) * SLOTB, qr, zero16, r32, hi); }
    else      { qkt(p[0], p[1], shm + DS_K + j0 * SLOTB, qr, zero16, r32, hi); qkt(p[2], p[3], shm + DS_K + (j0 + 1) * SLOTB, qr, zero16, r32, hi); qkt_half<0>(p[4], shm + DS_K + (j0 + 2) * SLOTB, qr, zero16, r32, hi); p[5] = zero16; }
    if (ng >= 0) { asm volatile("s_waitcnt lgkmcnt(0)" ::: "memory"); __builtin_amdgcn_s_barrier(); dswa_stage(true, false, nb, ng, nhg, nrres, nqb, K, V, shm, wid, lane); }
    const int ib = 192 + 32 * (wid & 1) + r32 - 4 * hi;
    if (qb == 0) {
#pragma unroll
        for (int jj = 0; jj < 3; ++jj) if (j0 + jj < 2) { p[2 * jj] = splat16(-INFINITY); p[2 * jj + 1] = splat16(-INFINITY); }
    }
    float mx = -INFINITY;
#pragma unroll
    for (int jj = 0; jj < 3; ++jj)
#pragma unroll
        for (int sub = 0; sub < 2; ++sub) { if (2 * jj + sub == tm) continue;
#pragma unroll
            for (int r = 0; r < 16; ++r) {
                const int cr = (r & 3) + 8 * (r >> 2);
                const float s = p[2 * jj + sub][r] + lut[ib - 64 * jj - 32 * sub - cr];
                p[2 * jj + sub][r] = s; mx = fmaxf(mx, s);
            } }
    { auto rr = __builtin_amdgcn_permlane32_swap(__float_as_uint(mx), __float_as_uint(mx), false, false); mx = fmaxf(__uint_as_float(rr[0]), __uint_as_float(rr[1])); }
    float l = 0.f;
#pragma unroll
    for (int t = 0; t < 6; ++t) { if (t == tm) continue;
#pragma unroll
        for (int r = 0; r < 16; ++r) { const float e = __builtin_amdgcn_exp2f(p[t][r] - mx); p[t][r] = e; l += e; } }
    { auto rr = __builtin_amdgcn_permlane32_swap(__float_as_uint(l), __float_as_uint(l), false, false); l = __uint_as_float(rr[0]) + __uint_as_float(rr[1]); }
    f32x16 o[2]; o[0] = splat16(zf); o[1] = splat16(zf);
    const int vb0 = (int)(lds0 + DS_V) + ((lane >> 4) & 1) * 32 + (lane & 3) * 8 + (4 * hi + ((lane & 15) >> 2)) * 64;
#pragma unroll
    for (int jj = 0; jj < 3; ++jj) {
        const f32x16& P0 = p[2 * jj]; const f32x16& P1 = p[2 * jj + 1];
        const u32x4 w0 = (u32x4){cvtpk_s(P0[0], P0[1]), cvtpk_s(P0[2], P0[3]), cvtpk_s(P0[4], P0[5]), cvtpk_s(P0[6], P0[7])};
        const u32x4 w1 = (u32x4){cvtpk_s(P0[8], P0[9]), cvtpk_s(P0[10], P0[11]), cvtpk_s(P0[12], P0[13]), cvtpk_s(P0[14], P0[15])};
        const u32x4 w2 = (u32x4){cvtpk_s(P1[0], P1[1]), cvtpk_s(P1[2], P1[3]), cvtpk_s(P1[4], P1[5]), cvtpk_s(P1[6], P1[7])};
        const u32x4 w3 = (u32x4){cvtpk_s(P1[8], P1[9]), cvtpk_s(P1[10], P1[11]), cvtpk_s(P1[12], P1[13]), cvtpk_s(P1[14], P1[15])};
        if (2 * jj == tm) pv_half<1>(o, vb0 + (j0 + jj) * SLOTB, __builtin_bit_cast(bf16x8, w2), __builtin_bit_cast(bf16x8, w3));
        else if (2 * jj + 1 == tm) pv_half<0>(o, vb0 + (j0 + jj) * SLOTB, __builtin_bit_cast(bf16x8, w0), __builtin_bit_cast(bf16x8, w1));
        else pv(o, vb0 + (j0 + jj) * SLOTB, __builtin_bit_cast(bf16x8, w0), __builtin_bit_cast(bf16x8, w1), __builtin_bit_cast(bf16x8, w2), __builtin_bit_cast(bf16x8, w3));
    }
    if (ng >= 0) { asm volatile("s_waitcnt lgkmcnt(0)" ::: "memory"); __builtin_amdgcn_s_barrier(); dswa_stage(false, true, nb, ng, nhg, nrres, nqb, K, V, shm, wid, lane);
        const bf16* Qn = Q + ((long)nb * SEQ + nrres + (long)(1 << (2 * ng)) * (256 * nqb + 32 * wid + r32)) * PIT + (ng * 4 + nhg) * 64;
#pragma unroll
        for (int d0 = 0; d0 < 4; ++d0) qn[d0] = *reinterpret_cast<const bf16x8*>(&Qn[d0 * 16 + hi * 8]); }
    LAS float* wsf = wsfb + wid * 64;
    if (hi == 0) { wsf[r32] = l; lse[(tok0 + (long)d * (mq0 + r32)) * 4 + hg] = mx + __log2f(l); }
    asm volatile("s_waitcnt lgkmcnt(0)" ::: "memory");
    float rli[16];
#pragma unroll
    for (int r = 0; r < 16; ++r) rli[r] = __builtin_amdgcn_rcpf(wsf[crow(r, hi)]);
    { bf16* stg = (bf16*)(shm + DS_OST) + wid * 2048;
#pragma unroll
      for (int r = 0; r < 16; ++r) { const int orow = crow(r, hi);
#pragma unroll
          for (int d0 = 0; d0 < 2; ++d0) stg[orow * 64 + d0 * 32 + r32] = __float2bfloat16(o[d0][r] * rli[r]); }
      asm volatile("s_waitcnt lgkmcnt(0)" ::: "memory");
#pragma unroll
      for (int i = 0; i < 4; ++i) { const int row = i * 8 + (lane >> 3), ch = lane & 7; const u32x4 v = *(const u32x4*)(stg + row * 64 + ch * 8);
          *(u32x4*)(Og + (tok0 + (long)d * (mq0 + row)) * OAW + hg * 64 + ch * 8) = v; } }
    asm volatile("s_waitcnt lgkmcnt(0)" ::: "memory"); __syncthreads();
}
#undef SBAR
#undef WAIT_BAR
#undef KADD
#undef PKW
#undef PAF
#undef VFR
#undef PIN
#undef MX3
}

constexpr int NWAVES = 8;
constexpr int N_LAUNCHES = MK_N_LAUNCHES;
constexpr int N_PHASES = 10;
struct Args { const float* in[20]; float* out; unsigned char* ws; int ph_lo, ph_hi, li, pad; };

struct TrItem { const float* src; unsigned char* dst; int ldn, ldkb; bool fp8; };
__device__ __forceinline__ void tr_load(const TrItem& d, f32x4 (&t)[8], int lane) {
    const int kq = lane >> 3, n4 = (lane & 7) * 4; const GAS float* src = (const GAS float*)(d.src + (size_t)kq * d.ldn + n4);
#pragma unroll
    for (int i = 0; i < 8; ++i) t[i] = __builtin_nontemporal_load((const GAS f32x4*)(src + (size_t)(8 * i) * d.ldn));
}
__device__ __forceinline__ void tr_store(const TrItem& d, const f32x4 (&t)[8], LAS float* scr, int lane) {
    { const int kq = lane >> 3, n4 = (lane & 7) * 4;
#pragma unroll
      for (int i = 0; i < 8; ++i) { LAS float* p = scr + (8 * i + kq) * 33 + n4; p[0] = t[i].x; p[1] = t[i].y; p[2] = t[i].z; p[3] = t[i].w; } }
    LDS_WAIT(); asm volatile("" ::: "memory");
    const int c = lane & 7;
    if (d.fp8) {
        const int c4 = lane & 3;
#pragma unroll
        for (int j = 0; j < 2; ++j) { const int n = (lane >> 2) + 16 * j; const LAS float* s = scr + (16 * c4) * 33 + n; u32x4 o;
            o.x = pk4_fp8(s[0 * 33] * SC_W, s[1 * 33] * SC_W, s[2 * 33] * SC_W, s[3 * 33] * SC_W); o.y = pk4_fp8(s[4 * 33] * SC_W, s[5 * 33] * SC_W, s[6 * 33] * SC_W, s[7 * 33] * SC_W);
            o.z = pk4_fp8(s[8 * 33] * SC_W, s[9 * 33] * SC_W, s[10 * 33] * SC_W, s[11 * 33] * SC_W); o.w = pk4_fp8(s[12 * 33] * SC_W, s[13 * 33] * SC_W, s[14 * 33] * SC_W, s[15 * 33] * SC_W);
            *(GAS u32x4*)(d.dst + (size_t)n * d.ldkb + 16 * c4) = o; }
    } else
#pragma unroll
    for (int j = 0; j < 4; ++j) { const int n = (lane >> 3) + 8 * j; const LAS float* s = scr + (8 * c) * 33 + n;
        { u32x4 o; o.x = pk2(s[0 * 33], s[1 * 33]); o.y = pk2(s[2 * 33], s[3 * 33]); o.z = pk2(s[4 * 33], s[5 * 33]); o.w = pk2(s[6 * 33], s[7 * 33]);
            *(GAS u32x4*)(d.dst + (size_t)n * d.ldkb + 16 * c) = o; } }
    LDS_WAIT(); asm volatile("" ::: "memory");
}

__device__ __forceinline__ int opaque_tid() { int t_ = threadIdx.x; asm volatile("" : "+v"(t_)); return t_; }
__device__ __forceinline__ int opaque_lane() { int l_ = threadIdx.x; asm volatile("" : "+v"(l_)); return l_ & 63; }
__global__ void __launch_bounds__(NWAVES * 64, 2) fwd(Args args) {
    extern __shared__ __attribute__((aligned(16))) unsigned char lds[];
    LAS unsigned char* L = (LAS unsigned char*)lds;
    volatile LAS unsigned* MISC = (volatile LAS unsigned*)(L + X_MISC);
    const int tid = threadIdx.x, lane = tid & 63, wave = __builtin_amdgcn_readfirstlane(tid >> 6);
    const int G = gridDim.x; const int bx = blockIdx.x; const int vcu = (G % 8 == 0) ? (bx % 8) * (G / 8) + bx / 8 : bx;
    unsigned char* ws = args.ws;
    gu32* ctl = (gu32*)(ws + WS_CTL);
#if EPDUP_MODE == 2
    if (tid == 0) pg8::epdup_base = ws + WS_WIN8; __syncthreads();
#endif
    const float* x = args.in[0]; float* out = args.out;
    bf16_t* Win_t = (bf16_t*)(ws + WS_WIN); bf16_t* Wab_t = (bf16_t*)(ws + WS_WAB); bf16_t* Wo_t = (bf16_t*)(ws + WS_WO);
    bf16_t* Wgu_t = (bf16_t*)(ws + WS_WGU); bf16_t* Wd_t = (bf16_t*)(ws + WS_WD);
    float* LF = (float*)(ws + WS_LF); float* CB = (float*)(ws + WS_CB);
    float* RSTDS = (float*)(ws + WS_RSTD);
    int* TOKL = (int*)(ws + WS_TOKL); int* TINFO = (int*)(ws + WS_TINFO); float* RGATE = (float*)(ws + WS_RGATE);
    bf16_t* HB = (bf16_t*)(ws + WS_H);
    bf16_t* QA = (bf16_t*)(ws + WS_QA); bf16_t* KA = (bf16_t*)(ws + WS_KA); bf16_t* VA = (bf16_t*)(ws + WS_VA);
    bf16_t* QBp = (bf16_t*)(ws + WS_QB); bf16_t* KBp = (bf16_t*)(ws + WS_KB); bf16_t* VBp = (bf16_t*)(ws + WS_VB);
    bf16_t* GATE = (bf16_t*)(ws + WS_GATE); bf16_t* OG = (bf16_t*)(ws + WS_OG); float* LSE = (float*)(ws + WS_LSE);
    bf16_t* OAB = (bf16_t*)(ws + WS_OAB); bf16_t* MRG = (bf16_t*)(ws + WS_MRG);
    bf16_t* MID = (bf16_t*)(ws + WS_MID); bf16_t* YB = (bf16_t*)(ws + WS_Y);

    for (int u = tid; u < 512 / 4; u += NWAVES * 64) ((LAS unsigned*)(L + X_MISC))[u] = 0u;
    __syncthreads();
    XcdBarrier bar; bar.bar = (unsigned*)(ctl + CW_BAR); bar.x = 0; bar.st = nullptr;
    if (N_LAUNCHES == 1) bar = xcd_barrier_post((unsigned*)(ctl + CW_BAR), MISC + 8);
#define GRID_BAR() do { if (N_LAUNCHES == 1) xcd_barrier(bar); } while (0)
    const int lo = args.ph_lo, hi_ph = args.ph_hi;
#ifndef PH_MASK
#define PH_MASK 0x3ff
#endif
#define IN(k) ((((PH_MASK) >> (k)) & 1) && lo <= (k) && (k) < hi_ph)
#define BOTH(k) (IN(k) && IN((k) + 1))
    const int gw = vcu * NWAVES + wave, NGW = G * NWAVES;

    constexpr int I_IN = 16 * 184, I_A = 4 * 32, I_B = 8 * 32, I_O = 16 * 32, I_GU = 16 * 64, I_D = 16 * 32;
    constexpr int NITEMS = I_IN + I_A + I_B + I_O + NEXP * (I_GU + I_D), NSMALL = I_IN + I_A + I_B + I_O; static_assert(NITEMS - NSMALL == 768 * 64, "conversion chunks");
#define TR_DECODE(D, IT) do { int r = (IT); \
            if (r < I_IN) { const int kb = r / 184, nb = r % 184, pn = nb >> 3, q = nb & 7, bj = q >> 2, wc = q & 3; \
                const int srcc = (pn < 15 ? 256 * pn : COL_G + 256 * (pn - 15)) + 64 * wc + 32 * bj; \
                const bool f8 = true; const int idx = pn; const int r0 = 256 * idx + 32 * (nb & 7);            \
                D.src = args.in[2] + (size_t)(64 * kb) * WIN_LD + srcc; D.ldn = WIN_LD; D.fp8 = f8; D.ldkb = f8 ? 1024 : 2048; \
                D.dst = ws + WS_WIN8ALL + (size_t)r0 * 1024 + 64 * kb; break; } r -= I_IN; \
            if (r < I_A) { D.src = args.in[10] + (size_t)(64 * (r / 32)) * 1024 + 32 * (r % 32); D.ldn = 1024; D.fp8 = false; D.ldkb = 1536; D.dst = ws + WS_WAB + (size_t)(32 * (r % 32)) * 1536 + 128 * (r / 32); break; } r -= I_A; \
            if (r < I_B) { D.src = args.in[11] + (size_t)(64 * (r / 32)) * 1024 + 32 * (r % 32); D.ldn = 1024; D.fp8 = false; D.ldkb = 1536; D.dst = ws + WS_WAB + (size_t)(32 * (r % 32)) * 1536 + 512 + 128 * (r / 32); break; } r -= I_B; \
            if (r < I_O) { D.src = args.in[12] + (size_t)(64 * (r / 32)) * 1024 + 32 * (r % 32); D.ldn = 1024; D.fp8 = false; D.ldkb = 2048; D.dst = ws + WS_WO + (size_t)(32 * (r % 32)) * 2048 + 128 * (r / 32); break; } r -= I_O; \
            if (r < NEXP * I_GU) { const int e = r / I_GU, rr = r % I_GU, kb = rr / 64, nb = rr % 64, pn = nb >> 3, q = nb & 7, bj = q >> 2; \
                D.src = args.in[16] + (size_t)e * 1024 * 2048 + (size_t)(64 * kb) * 2048 + bj * 1024 + 128 * pn + 32 * (q & 3); D.ldn = 2048; D.fp8 = true; D.ldkb = 1024; \
                D.dst = ws + WS_WGU + (size_t)e * 2048 * 1024 + (size_t)(32 * nb) * 1024 + 64 * kb; break; } r -= NEXP * I_GU; \
            { const int e = r / I_D, rr = r % I_D; D.src = args.in[18] + (size_t)e * 1024 * 1024 + (size_t)(64 * (rr / 32)) * 1024 + 32 * (rr % 32); D.ldn = 1024; D.fp8 = true; D.ldkb = 1024; \
              D.dst = ws + WS_WD + (size_t)e * 1024 * 1024 + (size_t)(32 * (rr % 32)) * 1024 + 64 * (rr / 32); } } while (0)
    if (IN(0)) {
        const int tid = opaque_tid(); const int lane = tid & 63;
        LAS float* scr = (LAS float*)(L + wave * 16384);
        if (gw < NSMALL) {
            TrItem cur; TR_DECODE(cur, gw); f32x4 tc[8]; tr_load(cur, tc, lane);
            for (int it = gw; it < NSMALL; it += NGW) {
                TrItem nxt = cur; f32x4 tn[8]; const bool has = it + NGW < NSMALL;
                if (has) { TR_DECODE(nxt, it + NGW); }
                if (has) tr_load(nxt, tn, lane);
                tr_store(cur, tc, scr, lane);
                cur = nxt;
#pragma unroll
                for (int i = 0; i < 8; ++i) tc[i] = tn[i];
            }
        }
        __syncthreads();
        LAS float* wf = (LAS float*)L;
        { float wv_[16];
#pragma unroll
          for (int q = 0; q < 16; ++q) { const int i = tid + NWAVES * 64 * q, k = i >> 3, j = i & 7; wv_[q] = args.in[2][(size_t)k * WIN_LD + COL_F + j]; }
#pragma unroll
          for (int q = 0; q < 16; ++q) { const int i = tid + NWAVES * 64 * q, k = i >> 3, j = i & 7; wf[j * 1024 + k] = wv_[q]; } }
        __syncthreads();
        const float* g1 = args.in[1]; const float* bfg = args.in[3];
        f32x4 gv[4];
#pragma unroll
        for (int j = 0; j < 4; ++j) gv[j] = *((const f32x4*)g1 + 64 * j + lane);
        for (int m0 = gw; m0 < NTOK; m0 += 2 * NGW) {
            const int m1 = (m0 + NGW < NTOK) ? m0 + NGW : m0;
            f32x4 v[2][4]; float ssq[2];
#pragma unroll
            for (int a = 0; a < 2; ++a) { const GAS f32x4* xr = (const GAS f32x4*)(x + (size_t)(a ? m1 : m0) * DM) + lane;
#pragma unroll
                for (int j = 0; j < 4; ++j) v[a][j] = __builtin_nontemporal_load(&xr[64 * j]); }
#pragma unroll
            for (int a = 0; a < 2; ++a) { float s = 0.f;
#pragma unroll
                for (int j = 0; j < 4; ++j) s += (v[a][j].x * v[a][j].x + v[a][j].y * v[a][j].y) + (v[a][j].z * v[a][j].z + v[a][j].w * v[a][j].w);
                ssq[a] = s; }
#pragma unroll
            for (int a = 0; a < 2; ++a) {
                const int m = a ? m1 : m0;
                const float rstd = __builtin_amdgcn_rsqf(wave_sum(ssq[a]) * (1.f / DM) + RMS_EPS);
                LAS unsigned* hst = (LAS unsigned*)(L + 65536 + wave * 2048 + a * 1024);
#pragma unroll
                for (int j = 0; j < 4; ++j) { v[a][j] = v[a][j] * rstd * gv[j]; hst[64 * j + lane] = pk4_fp8s(v[a][j].x * SC_H2, v[a][j].y * SC_H2, v[a][j].z * SC_H2, v[a][j].w * SC_H2); }
                LDS_WAIT();
                *((GAS u32x4*)(ws + WS_H8 + (size_t)m * DM) + lane) = *((const LAS u32x4*)hst + lane);
                float fl[8];
#pragma unroll
                for (int e = 0; e < 8; ++e) { float acc_ = 0.f;
#pragma unroll
                    for (int j = 0; j < 4; ++j) { const f32x4 w = *((const LAS f32x4*)(wf + e * 1024) + 64 * j + lane); acc_ += (v[a][j].x * w.x + v[a][j].y * w.y) + (v[a][j].z * w.z + v[a][j].w * w.w); }
                    fl[e] = acc_; }
                const bool c5 = lane & 32, c4 = lane & 16, c3 = lane & 8;
                float r4[4], r2[2], r1;
#pragma unroll
                for (int e = 0; e < 4; ++e) { const float keep = c5 ? fl[4 + e] : fl[e], send = c5 ? fl[e] : fl[4 + e]; r4[e] = keep + __shfl_xor(send, 32); }
#pragma unroll
                for (int e = 0; e < 2; ++e) { const float keep = c4 ? r4[2 + e] : r4[e], send = c4 ? r4[e] : r4[2 + e]; r2[e] = keep + __shfl_xor(send, 16); }
                { const float keep = c3 ? r2[1] : r2[0], send = c3 ? r2[0] : r2[1]; r1 = keep + __shfl_xor(send, 8); }
                r1 += __shfl_xor(r1, 4); r1 += __shfl_xor(r1, 2); r1 += __shfl_xor(r1, 1);
                if ((lane & 7) == 0) { const int e = lane >> 3; const float z = r1 + bfg[e]; LF[(size_t)m * 8 + e] = fminf(z, 0.f) - log1pf(__expf(-fabsf(z))); }
            }
        }
        if (BOTH(0)) GRID_BAR();
    }

    if (IN(1)) {
        const int tid = opaque_tid(); const int lane = tid & 63;
        for (int bh = vcu; bh < 64; bh += G) {
            const int b = bh >> 3, h = bh & 7; const float* lf = LF + ((size_t)b * SEQ + 8 * tid) * 8 + h;
            LAS float* wt = (LAS float*)(L + X_WS);
            float v[8]; float sacc = 0.f;
#pragma unroll
            for (int j = 0; j < 8; ++j) v[j] = lf[j * 8];
#pragma unroll
            for (int j = 0; j < 8; ++j) { sacc += v[j]; v[j] = sacc; }
            float incl = sacc;
#pragma unroll
            for (int o = 1; o < 64; o <<= 1) { const float t = __shfl_up(incl, o); if (lane >= o) incl += t; }
            if (lane == 63) wt[wave] = incl;
            __syncthreads();
            float basev = 0.f;
#pragma unroll
            for (int w = 0; w < 8; ++w) basev += (w < wave) ? wt[w] : 0.f;
            const float excl = basev + incl - sacc;
            f32x4 o0, o1;
            o0.x = (excl + v[0]) * LOG2E; o0.y = (excl + v[1]) * LOG2E; o0.z = (excl + v[2]) * LOG2E; o0.w = (excl + v[3]) * LOG2E;
            o1.x = (excl + v[4]) * LOG2E; o1.y = (excl + v[5]) * LOG2E; o1.z = (excl + v[6]) * LOG2E; o1.w = (excl + v[7]) * LOG2E;
            f32x4* cb = (f32x4*)(CB + (size_t)bh * SEQ + 8 * tid); cb[0] = o0; cb[1] = o1;
            __syncthreads();
        }
        { LAS float* nwl = (LAS float*)(L + X_NW);
          if (tid < 256) { const int j = tid >> 6, c = tid & 63; const float v = (j == 0 ? args.in[5] : (j == 1 ? args.in[6] : (j == 2 ? args.in[7] : args.in[8])))[c]; nwl[tid] = ((j & 1) == 0) ? v * QSCALE : v; }
          __syncthreads(); }
        { pg8::StaticOrder S; S.init((const bf16_t*)(ws + WS_H8), (const bf16_t*)(ws + WS_WIN8ALL), NTOK, 23 * 256, DM / 2, G, bx);
          pg8::EpiInProj<0> E{ws, (const LAS float*)(L + X_NW), args.in[4]};
          pg8::gemm_phase<pg8::EpiInProj<0>, pg8::StaticOrder, E8_H2>(L, S, E); }
        if (BOTH(1)) GRID_BAR();
    }

    if (IN(2)) {
        const int tid = opaque_tid(); const int lane = tid & 63;
        LAS int* qs = (LAS int*)(L + X_Q);
        int n_dswa = 0;
        bool popped = false;
        { bool dswa_pre = false; int dswa_head = -1; bf16x8 dswa_q[4];
#pragma unroll
          for (int d0 = 0; d0 < 4; ++d0) dswa_q[d0] = (bf16x8){0, 0, 0, 0, 0, 0, 0, 0};
          for (int it = vcu; it < 1536; it += G) {
                const int uidx = it, g = uidx >> 9, rem = uidx & 511, b = rem >> 6, hg = (rem >> 4) & 3, w = rem & 15;
                const int nqb = 16 >> (2 * g), rres = w / nqb, qb = w % nqb;
                const int nu = (it + G < 1536) ? it + G : -1; int ng = -1, nb2 = 0, nhg = 0, nrres = 0, nqb2 = 0;
                if (nu >= 0) { ng = nu >> 9; const int nrem = nu & 511, nw = nrem & 15, nn = 16 >> (2 * ng); nb2 = nrem >> 6; nhg = (nrem >> 4) & 3; nrres = nw / nn; nqb2 = nw % nn; }
                att::dswa_unit(b, g, hg, rres, qb, (const att::bf16*)QA, (const att::bf16*)KA, (const att::bf16*)VA, (att::bf16*)(OG + (size_t)g * NTOK * OAW), LSE + (size_t)g * NTOK * 4, args.in[9],
                               (char*)lds, (LAS float*)(L + X_LUT), (LAS float*)(L + X_WS), dswa_pre, nb2, ng, nhg, nrres, nqb2, (g * 4 + hg) != dswa_head, dswa_q);
                dswa_pre = (nu >= 0); dswa_head = g * 4 + hg;
                ++n_dswa;
          } }
        if (tid < 64) {
            float a = fabsf(args.in[7][tid]), bq = fabsf(args.in[8][tid]);
#pragma unroll
            for (int o = 1; o < 64; o <<= 1) { a = fmaxf(a, __shfl_xor(a, o)); bq = fmaxf(bq, __shfl_xor(bq, o)); }
            if (tid == 0) ((LAS float*)qs)[2] = 40.0f + 2.04f * 64.0f * a * bq * QSCALE;
        }
        for (;;) {
            int it;
            if (popped) { it = qs[1]; popped = false; }
            else {
                __syncthreads();
                if (tid == 0) qs[0] = 1536 + (int)__hip_atomic_fetch_add(ctl + CW_QHEAD, 1u, RLX_AGENT);
                __syncthreads();
                it = qs[0]; }
            const bool leaving = (it >= 1536);
            if (leaving && n_dswa) {
                VM_WAIT(); __syncthreads();
                if (tid == 0) { __builtin_amdgcn_fence(__ATOMIC_RELEASE, "agent"); VM_WAIT(); __hip_atomic_fetch_add(ctl + CW_DSWA_DONE, (unsigned)n_dswa, RLX_AGENT); }
                n_dswa = 0;
            }
            if (it >= 3584) break;
            const int jq = it - 1536;
            if (it >= 1536 && jq < 1536 && (jq & 1)) {
                const int cc = jq >> 1; LAS float* scr = (LAS float*)(L + wave * 16384);
                const int ib = NSMALL + cc * 64 + wave * 8;
                TrItem ti3[3]; f32x4 tb3[3][8];
                TR_DECODE(ti3[0], ib); tr_load(ti3[0], tb3[0], lane); TR_DECODE(ti3[1], ib + 1); tr_load(ti3[1], tb3[1], lane);
                int nxv_c = 0;
#pragma unroll
                for (int i = 0; i < 8; ++i) {
                    if (i + 2 < 8) { TR_DECODE(ti3[(i + 2) % 3], ib + i + 2); tr_load(ti3[(i + 2) % 3], tb3[(i + 2) % 3], lane); }
                    if (i == 5 && tid == 0) nxv_c = 1536 + (int)__hip_atomic_fetch_add(ctl + CW_QHEAD, 1u, RLX_AGENT);
                    tr_store(ti3[i % 3], tb3[i % 3], scr, lane);
                }
                if (tid == 0) qs[1] = nxv_c;
                __syncthreads(); popped = true;
            } else if (it >= 1536 && it < 3328) {
                const int fi = jq < 1536 ? (jq >> 1) : jq - 768;
                const int qb = 15 - (fi >> 6), j = fi & 63, h = 7 - (j >> 3), b = j & 7;
                att::fox_unit<32>(b, h, qb, (const att::bf16*)QBp, (const att::bf16*)KBp, (const att::bf16*)VBp, (att::bf16*)OAB, CB, ((const LAS float*)qs)[2], (char*)lds, (unsigned*)(ctl + CW_QHEAD), qs + 1); popped = true;
            } else {
                if (tid == 0) { unsigned sp = 0; while (__hip_atomic_load(ctl + CW_DSWA_DONE, RLX_AGENT) < 1536u) { __builtin_amdgcn_s_sleep(2); if (++sp > (1u << 22)) break; }
                    __builtin_amdgcn_fence(__ATOMIC_ACQUIRE, "agent"); VM_WAIT(); }
                __syncthreads();
                const int c = it - 3328;
                for (int i0 = c * 4096 + tid; i0 < (c + 1) * 4096; i0 += 1024) {
                    float l0[2], l1[2], l2[2]; u32x4 a[2], bq[2], cq[2];
#pragma unroll
                    for (int q = 0; q < 2; ++q) { const int i = i0 + 512 * q, t = i >> 5, c8 = i & 31, hg = c8 >> 3;
                        l0[q] = LSE[(size_t)t * 4 + hg]; l1[q] = LSE[(size_t)NTOK * 4 + (size_t)t * 4 + hg]; l2[q] = LSE[(size_t)NTOK * 8 + (size_t)t * 4 + hg];
                        a[q] = __builtin_nontemporal_load((const u32x4*)(OG + (size_t)t * OAW + c8 * 8)); bq[q] = __builtin_nontemporal_load((const u32x4*)(OG + (size_t)NTOK * OAW + (size_t)t * OAW + c8 * 8)); cq[q] = __builtin_nontemporal_load((const u32x4*)(OG + (size_t)2 * NTOK * OAW + (size_t)t * OAW + c8 * 8)); }
                    asm volatile("" ::: "memory");
#pragma unroll
                    for (int q = 0; q < 2; ++q) { const int i = i0 + 512 * q, t = i >> 5, c8 = i & 31;
                        const float mx = fmaxf(l0[q], fmaxf(l1[q], l2[q]));
                        float w0 = __builtin_amdgcn_exp2f(l0[q] - mx), w1 = __builtin_amdgcn_exp2f(l1[q] - mx), w2 = __builtin_amdgcn_exp2f(l2[q] - mx);
                        const float inv = __builtin_amdgcn_rcpf(w0 + w1 + w2); w0 *= inv; w1 *= inv; w2 *= inv;
                        u32x4 o;
                        o.x = pk2(w0 * bflo(a[q].x) + w1 * bflo(bq[q].x) + w2 * bflo(cq[q].x), w0 * bfhi(a[q].x) + w1 * bfhi(bq[q].x) + w2 * bfhi(cq[q].x));
                        o.y = pk2(w0 * bflo(a[q].y) + w1 * bflo(bq[q].y) + w2 * bflo(cq[q].y), w0 * bfhi(a[q].y) + w1 * bfhi(bq[q].y) + w2 * bfhi(cq[q].y));
                        o.z = pk2(w0 * bflo(a[q].z) + w1 * bflo(bq[q].z) + w2 * bflo(cq[q].z), w0 * bfhi(a[q].z) + w1 * bfhi(bq[q].z) + w2 * bfhi(cq[q].z));
                        o.w = pk2(w0 * bflo(a[q].w) + w1 * bflo(bq[q].w) + w2 * bflo(cq[q].w), w0 * bfhi(a[q].w) + w1 * bfhi(bq[q].w) + w2 * bfhi(cq[q].w));
                        *(u32x4*)(OAB + (size_t)t * OABP + c8 * 8) = o; }
                }
            }
        }
        if (BOTH(2)) GRID_BAR();
    }

    if (IN(4)) {
        pg8::StaticOrder S; S.init(OAB, Wab_t, NTOK, DM, 768, G, bx); pg8::EpiMerge E{(const unsigned char*)GATE, MRG};
        pg8::gemm_phase<pg8::EpiMerge, pg8::StaticOrder>(L, S, E);
        if (BOTH(4)) GRID_BAR();
    }

    if (IN(5)) {
        pg8::StaticOrder S; S.init(MRG, Wo_t, NTOK, DM, DM, G, bx); pg8::EpiAtt E{x, (bf16_t*)(ws + WS_ATT)};
        pg8::gemm_phase<pg8::EpiAtt, pg8::StaticOrder>(L, S, E);
        if (BOTH(5)) GRID_BAR();
    }

    if (IN(6)) {
        const int tid = opaque_tid(); const int lane = tid & 63;
        const float* g2 = args.in[13]; const float* wr = args.in[14]; const float* br = args.in[15];
        constexpr int P6R = 12;
        u32x4 as8[P6R]; bool pre6 = false;
        const int fr = lane & 15, fq = lane >> 4;
        if (vcu < NTOK / 128) {
            const GAS u32x4* ar0 = (const GAS u32x4*)((const bf16_t*)(ws + WS_ATT) + (size_t)(vcu * 128 + wave * 16 + fr) * DM + 8 * fq);
#pragma unroll
            for (int st = 0; st < P6R; ++st) as8[st] = __builtin_nontemporal_load(&ar0[4 * st]);
            pre6 = true; }
        for (int idx0 = tid; idx0 < 32 * 128; idx0 += 4 * NWAVES * 64) {
          float w4[4][8];
#pragma unroll
          for (int q = 0; q < 4; ++q) { const int idx = idx0 + q * NWAVES * 64, e = idx & 31, c = idx >> 5;
#pragma unroll
            for (int i = 0; i < 8; ++i) w4[q][i] = wr[(size_t)(8 * c + i) * 32 + e] * g2[8 * c + i]; }
#pragma unroll
          for (int q = 0; q < 4; ++q) { const int idx = idx0 + q * NWAVES * 64, e = idx & 31, c = idx >> 5;
            float (&w)[8] = w4[q];
            u32x4 hi4, lo4; unsigned hh[8];
#pragma unroll
            for (int i = 0; i < 8; ++i) hh[i] = f2bf(w[i]);
            hi4.x = hh[0] | (hh[1] << 16); hi4.y = hh[2] | (hh[3] << 16); hi4.z = hh[4] | (hh[5] << 16); hi4.w = hh[6] | (hh[7] << 16);
            lo4.x = pk2(w[0] - bf2f((unsigned short)hh[0]), w[1] - bf2f((unsigned short)hh[1])); lo4.y = pk2(w[2] - bf2f((unsigned short)hh[2]), w[3] - bf2f((unsigned short)hh[3]));
            lo4.z = pk2(w[4] - bf2f((unsigned short)hh[4]), w[5] - bf2f((unsigned short)hh[5])); lo4.w = pk2(w[6] - bf2f((unsigned short)hh[6]), w[7] - bf2f((unsigned short)hh[7]));
            const int off = e * 2048 + ((c ^ (e & 15)) << 4);
            *(LAS u32x4*)(L + off) = hi4; *(LAS u32x4*)(L + 65536 + off) = lo4; } }
        { const float ga_ = g2[tid], gb_ = g2[tid + NWAVES * 64]; ((LAS float*)(L + X_G2))[tid] = ga_; ((LAS float*)(L + X_G2))[tid + NWAVES * 64] = gb_; }
        LAS int* lcnt = (LAS int*)(L + X_RCNT); LAS int* lbase = lcnt + 32;
        LAS int* rsel = (LAS int*)(L + X_RSEL); LAS float* rgt = (LAS float*)(L + X_RSEL + 2048); LAS float* rstl = (LAS float*)(L + X_RSTD);
        float brl[2][4];
#pragma unroll
        for (int n = 0; n < 2; ++n)
#pragma unroll
            for (int r = 0; r < 4; ++r) brl[n][r] = br[16 * n + 4 * fq + r];
        for (int ch = vcu; ch < NTOK / 128; ch += G) {
            if (tid < 32) lcnt[tid] = 0;
            __syncthreads();
            const int tok = ch * 128 + wave * 16 + fr;
            const GAS u32x4* ar = (const GAS u32x4*)((const bf16_t*)(ws + WS_ATT) + (size_t)tok * DM + 8 * fq);
            GAS unsigned char* h16 = (GAS unsigned char*)HB + (size_t)tok * DM + 8 * (fq & 2) + 32 * (fq & 1);
            u32x2 w8p = {0u, 0u};
            f32x4 acc[2]; acc[0] = (f32x4){0.f, 0.f, 0.f, 0.f}; acc[1] = acc[0];
            float ssq = 0.f;
            const LAS f32x4* g2l = (const LAS f32x4*)(L + X_G2) + 2 * fq;
#define P6_LOAD(slot, stv) do { as8[slot] = __builtin_nontemporal_load(&ar[4 * (stv)]); } while (0)
            if (!pre6) {
#pragma unroll
                for (int st = 0; st < P6R; ++st) P6_LOAD(st, st); }
            pre6 = false;
#pragma unroll
            for (int st = 0; st < 32; ++st) { const int slot = st % P6R;
                    const u32x4 aq = as8[slot]; const f32x4 ga = g2l[8 * st], gb = g2l[8 * st + 1];
                    const f32x4 x0 = {bflo(aq.x), bfhi(aq.x), bflo(aq.y), bfhi(aq.y)}, x1v = {bflo(aq.z), bfhi(aq.z), bflo(aq.w), bfhi(aq.w)};
                    if (st + P6R < 32) P6_LOAD(slot, st + P6R);
                    ssq += (x0.x * x0.x + x0.y * x0.y) + (x0.z * x0.z + x0.w * x0.w) + (x1v.x * x1v.x + x1v.y * x1v.y) + (x1v.z * x1v.z + x1v.w * x1v.w);
                    { u32x2 w8; w8.x = pk4_fp8s(x0.x * ga.x * SC_H2, x0.y * ga.y * SC_H2, x0.z * ga.z * SC_H2, x0.w * ga.w * SC_H2); w8.y = pk4_fp8s(x1v.x * gb.x * SC_H2, x1v.y * gb.y * SC_H2, x1v.z * gb.z * SC_H2, x1v.w * gb.w * SC_H2);
                      if (st & 1) {
                          const auto sa = __builtin_amdgcn_permlane16_swap(w8p.x, w8.x, false, false), sb = __builtin_amdgcn_permlane16_swap(w8p.y, w8.y, false, false);
                          u32x4 o16; o16.x = sa[0]; o16.y = sb[0]; o16.z = sa[1]; o16.w = sb[1];
                          *(GAS u32x4*)((GAS unsigned char*)h16 + 32 * (st - 1)) = o16; }
                      w8p = w8; }
                    const bf16x8 ah = __builtin_bit_cast(bf16x8, aq);
#pragma unroll
                    for (int n = 0; n < 2; ++n) { const int off = (16 * n + fr) * 2048 + (((4 * st + fq) ^ fr) << 4);
                        const bf16x8 wh = *(const LAS bf16x8*)(L + off), wl = *(const LAS bf16x8*)(L + 65536 + off);
                        acc[n] = __builtin_amdgcn_mfma_f32_16x16x32_bf16(wh, ah, acc[n], 0, 0, 0);
                        acc[n] = __builtin_amdgcn_mfma_f32_16x16x32_bf16(wl, ah, acc[n], 0, 0, 0); }
            }
#undef P6_LOAD
            ssq += __shfl_xor(ssq, 16); ssq += __shfl_xor(ssq, 32);
            const float rstd = __builtin_amdgcn_rsqf(ssq * (1.f / DM) + RMS_EPS);
            float lg[2][4];
#pragma unroll
            for (int n = 0; n < 2; ++n)
#pragma unroll
                for (int r = 0; r < 4; ++r) lg[n][r] = acc[n][r] * rstd + brl[n][r];
            float tv[4]; int ti[4];
#pragma unroll
            for (int k = 0; k < 4; ++k) { float bv = -INFINITY; int bi = 64;
#pragma unroll
                for (int n = 0; n < 2; ++n)
#pragma unroll
                    for (int r = 0; r < 4; ++r) { const int id = 16 * n + 4 * fq + r; if (lg[n][r] > bv) { bv = lg[n][r]; bi = id; } }
#pragma unroll
                for (int o = 16; o <= 32; o <<= 1) { const float ov = __shfl_xor(bv, o); const int oi = __shfl_xor(bi, o); if (ov > bv || (ov == bv && oi < bi)) { bv = ov; bi = oi; } }
                tv[k] = bv; ti[k] = bi;
#pragma unroll
                for (int n = 0; n < 2; ++n)
#pragma unroll
                    for (int r = 0; r < 4; ++r) if (16 * n + 4 * fq + r == bi) lg[n][r] = -INFINITY; }
            const float e1 = __expf(tv[1] - tv[0]), e2 = __expf(tv[2] - tv[0]), e3 = __expf(tv[3] - tv[0]); const float inv = 1.0f / (1.0f + e1 + e2 + e3);
            { const int e = fq == 0 ? ti[0] : (fq == 1 ? ti[1] : (fq == 2 ? ti[2] : ti[3])); const float gt = (fq == 0 ? 1.0f : (fq == 1 ? e1 : (fq == 2 ? e2 : e3))) * inv;
              const int rank = __hip_atomic_fetch_add(lcnt + e, 1, __ATOMIC_RELAXED, __HIP_MEMORY_SCOPE_WORKGROUP); const int tl = wave * 16 + fr;
              rsel[tl * 4 + fq] = (e << 16) | rank; rgt[tl * 4 + fq] = gt; if (fq == 0) rstl[tl] = rstd; }
            __syncthreads();
            if (tid < 32) lbase[tid] = (int)__hip_atomic_fetch_add(ctl + CW_ECNT + 64 * tid, (unsigned)lcnt[tid], RLX_AGENT);
            __syncthreads();
            { const int sel = rsel[tid], e = sel >> 16, pos = lbase[e] + (sel & 0xffff), t = ch * 128 + (tid >> 2);
              TOKL[(size_t)e * ECAP + pos] = t; RGATE[(size_t)e * ECAP + pos] = rgt[tid]; RSTDS[(size_t)e * ECAP + pos] = rstl[tid >> 2]; TINFO[(size_t)t * 4 + (tid & 3)] = (e << 16) | pos; }
            __syncthreads();
        }
        if (BOTH(6)) GRID_BAR();
    }

    LAS int* tpre = (LAS int*)(L + X_TPRE); LAS int* ecnt = tpre + 64;
    if (IN(7) || IN(8) || IN(9)) {
        const int tid = opaque_tid();
        if (tid < 32) ecnt[tid] = (int)__hip_atomic_load(ctl + CW_ECNT + 64 * tid, RLX_AGENT);
        __syncthreads();
        if (tid < 64) {
            const int nt_e = (tid < NEXP) ? ((ecnt[tid < NEXP ? tid : 0] + 255) >> 8) : 0; int inc = nt_e;
#pragma unroll
            for (int o = 1; o < 32; o <<= 1) { const int t_ = __shfl_up(inc, o); if ((tid & 63) >= o) inc += t_; }
            if (tid < NEXP) tpre[tid] = inc - nt_e;
            if (tid == NEXP - 1) tpre[NEXP] = inc; }
        __syncthreads();
    }

    if (IN(7)) {
        pg8::ExpertOrder<true, 0> S; S.A = HB; S.Bt = Wgu_t; S.K = DM / 2; S.N = 2048; S.tokl = TOKL; S.tpre = tpre; S.ecnt = ecnt; S.nN = 8; S.G = G; S.c = bx;
        pg8::EpiSwiglu E{args.in[17], (unsigned char*)MID, RSTDS, ecnt};
        pg8::gemm_phase<pg8::EpiSwiglu, pg8::ExpertOrder<true, 0>, E8_H2>(L, S, E);
        if (BOTH(7)) GRID_BAR();
    }
    if (IN(8)) {
        pg8::ExpertOrder<false, 0> S; S.A = MID; S.Bt = Wd_t; S.K = DM / 2; S.N = 1024; S.tokl = TOKL; S.tpre = tpre; S.ecnt = ecnt; S.nN = 4; S.G = G; S.c = bx;
        pg8::EpiDown E{args.in[19], RGATE, (unsigned char*)YB, ecnt};
        pg8::gemm_phase<pg8::EpiDown, pg8::ExpertOrder<false, 0>, E8_MID>(L, S, E);
        if (BOTH(8)) GRID_BAR();
    }
    if (IN(9)) {
        const int tid = opaque_tid(); const int lane = tid & 63;
        for (int m0 = gw; m0 < NTOK; m0 += 2 * NGW) {
            const bool two = (m0 + NGW < NTOK); const int m1 = two ? m0 + NGW : m0;
            f32x4 v[2][4]; int info[2][4];
            u32x2 av[2][4];
#pragma unroll
            for (int a = 0; a < 2; ++a) { const int m = a ? m1 : m0; const GAS u32x2* ar = (const GAS u32x2*)((const bf16_t*)(ws + WS_ATT) + (size_t)m * DM) + lane;
                { const u32x4 ti = *(const u32x4*)(TINFO + (size_t)m * 4); info[a][0] = (int)ti.x; info[a][1] = (int)ti.y; info[a][2] = (int)ti.z; info[a][3] = (int)ti.w; }
#pragma unroll
                for (int j = 0; j < 4; ++j) av[a][j] = __builtin_nontemporal_load(&ar[64 * j]); }
#pragma unroll
            for (int a = 0; a < 2; ++a)
#pragma unroll
                for (int j = 0; j < 4; ++j) { v[a][j].x = bflo(av[a][j].x); v[a][j].y = bfhi(av[a][j].x); v[a][j].z = bflo(av[a][j].y); v[a][j].w = bfhi(av[a][j].y); }
#pragma unroll
            for (int a = 0; a < 2; ++a)
#pragma unroll
                for (int k = 0; k < 4; ++k) { const int e = info[a][k] >> 16, pos = info[a][k] & 0xffff; const size_t row = (size_t)tpre[e] * 256 + pos;
                    const GAS unsigned* yr = (const GAS unsigned*)((const unsigned char*)YB + row * 1024) + lane;
#pragma unroll
                    for (int j = 0; j < 4; ++j) { const unsigned y = __builtin_nontemporal_load(&yr[64 * j]); const f32x2 lo = __builtin_amdgcn_cvt_pk_f32_fp8((int)y, false), hi = __builtin_amdgcn_cvt_pk_f32_fp8((int)y, true);
                        v[a][j].x += lo.x * (1.0f / SC_Y); v[a][j].y += lo.y * (1.0f / SC_Y); v[a][j].z += hi.x * (1.0f / SC_Y); v[a][j].w += hi.y * (1.0f / SC_Y); } }
            { GAS f32x4* xr = (GAS f32x4*)(out + (size_t)m0 * DM) + lane;
#pragma unroll
              for (int j = 0; j < 4; ++j) __builtin_nontemporal_store(v[0][j], &xr[64 * j]); }
            if (two) { GAS f32x4* xr = (GAS f32x4*)(out + (size_t)m1 * DM) + lane;
#pragma unroll
              for (int j = 0; j < 4; ++j) __builtin_nontemporal_store(v[1][j], &xr[64 * j]); }
        }
    }
#undef IN
#undef BOTH
#undef GRID_BAR
}

extern "C" void kernel_launch(void* const* d_in, const int* in_sizes, int n_in, void* d_out, int out_size, void* d_ws, size_t ws_size, hipStream_t stream) {
    static int grid = 0;
    if (grid == 0) {
        if (n_in != 20 || in_sizes[0] != NTOK * DM || out_size != NTOK * DM || ws_size < WS_END) {
            fprintf(stderr, "kernel_launch: unexpected shapes (n_in %d, in0 %d, out %d, ws %zu); nothing launched\n", n_in, n_in > 0 ? in_sizes[0] : -1, out_size, ws_size); grid = -1; return; }
        int dev = 0, cus = 0, per_cu = 0;
        if (hipGetDevice(&dev) != hipSuccess || hipDeviceGetAttribute(&cus, hipDeviceAttributeMultiprocessorCount, dev) != hipSuccess) { grid = -1; return; }
        if (hipFuncSetAttribute((const void*)fwd, hipFuncAttributeMaxDynamicSharedMemorySize, LDS_BYTES) != hipSuccess) { fprintf(stderr, "kernel_launch: hipFuncSetAttribute failed\n"); grid = -1; return; }
        if (hipOccupancyMaxActiveBlocksPerMultiprocessor(&per_cu, (const void*)fwd, NWAVES * 64, LDS_BYTES) != hipSuccess || per_cu < 1)
            fprintf(stderr, "kernel_launch: occupancy query reports %d workgroups per CU\n", per_cu);
        (void)hipGetLastError();
        grid = cus;
        if (cus < 80) { fprintf(stderr, "kernel_launch: %d CUs: the per-workgroup unit lists (63 units) need at least 80\n", cus); grid = -1; return; }
    }
    if (grid < 0) return;
    if (hipMemsetAsync((char*)d_ws + WS_CTL, 0, CTL_ZERO_BYTES, stream) != hipSuccess) return;
    Args a{};
    for (int i = 0; i < 20; ++i) a.in[i] = (const float*)d_in[i];
    a.out = (float*)d_out; a.ws = (unsigned char*)d_ws;
    if (N_LAUNCHES == 1) { a.ph_lo = 0; a.ph_hi = N_PHASES; a.li = 0; hipLaunchKernelGGL(fwd, dim3(grid), dim3(NWAVES * 64), LDS_BYTES, stream, a); }
    else for (int li = 0; li < N_PHASES; ++li) { a.ph_lo = li; a.ph_hi = li + 1; a.li = li; hipLaunchKernelGGL(fwd, dim3(grid), dim3(NWAVES * 64), LDS_BYTES, stream, a); }
}
```
